# Optimizing an MI355X kernel written in HIP

```python
import math
import jax, jax.numpy as jnp
from jax import lax
import numpy as np

D_MODEL = 1024
BATCH = 8
SEQ = 4096
DEPTH = 2
DEC_BATCH = 128
DEC_SEQ = 1
PAST_LEN = 16384
PAGE_SIZE = 128

HEAD_DIM = 64
SSM_GROUP = 16
SSM_WIDTH = 512
SSM_GROUPS = SSM_WIDTH // SSM_GROUP
SSM_STATE = 64
SWA_WINDOW = 128
SWA_Q_HEADS = 8
SWA_KV_HEADS = 2
DIL_PAIRS = ((128, 1), (512, 4), (2048, 16))
DIL_HEADS = 4
BAND = 128
N_BRANCH = 3
D_FF = 4 * D_MODEL
PLE_DIM = 256
EPS = 1e-6

SWA_Q_W = SWA_Q_HEADS * HEAD_DIM
SWA_KV_W = SWA_KV_HEADS * HEAD_DIM
DIL_W = DIL_HEADS * HEAD_DIM
SPLITS = (SSM_WIDTH, SWA_Q_W, SWA_KV_W, SWA_KV_W) + (DIL_W,) * (3 * len(DIL_PAIRS)) + (D_MODEL,) * N_BRANCH
D_IN = sum(SPLITS)

kernel_name = 'hybrid_s5_swa_dilated_decoder_step'


def rmsnorm(x, g):
    xf = x.astype(jnp.float32)
    y = xf * lax.rsqrt(jnp.mean(xf * xf, axis=-1, keepdims=True) + EPS)
    return (y * g.astype(jnp.float32)).astype(x.dtype)


def cplx_affine_combine(e1, e2):
    a1r, a1i, b1r, b1i = e1
    a2r, a2i, b2r, b2i = e2
    return (a2r * a1r - a2i * a1i,
            a2r * a1i + a2i * a1r,
            a2r * b1r - a2i * b1i + b2r,
            a2r * b1i + a2i * b1r + b2i)


def ssm_branch(u, h0, lw):
    n, t, _ = u.shape
    f32 = jnp.float32
    a_re, a_im = lw['a_re'].astype(f32), lw['a_im'].astype(f32)
    dt = jnp.exp(lw['log_dt'].astype(f32))[:, None]
    mag = jnp.exp(a_re * dt)
    lam_r, lam_i = mag * jnp.cos(a_im * dt), mag * jnp.sin(a_im * dt)
    den = a_re * a_re + a_im * a_im
    zr = ((lam_r - 1.0) * a_re + lam_i * a_im) / den
    zi = (lam_i * a_re - (lam_r - 1.0) * a_im) / den
    b_re, b_im = lw['b_re'].astype(f32), lw['b_im'].astype(f32)
    bb_r = zr[..., None] * b_re - zi[..., None] * b_im
    bb_i = zr[..., None] * b_im + zi[..., None] * b_re
    ug = jnp.swapaxes(u.astype(f32).reshape(n, t, SSM_GROUPS, SSM_GROUP), 0, 1)
    x_r = jnp.einsum('tngh,gph->tngp', ug, bb_r)
    x_i = jnp.einsum('tngh,gph->tngp', ug, bb_i)
    h0r, h0i = h0[..., 0].astype(f32), h0[..., 1].astype(f32)
    x_r = x_r.at[0].add(lam_r * h0r - lam_i * h0i)
    x_i = x_i.at[0].add(lam_r * h0i + lam_i * h0r)
    shape = (t, 1, SSM_GROUPS, SSM_STATE)
    _, _, s_r, s_i = lax.associative_scan(
        cplx_affine_combine,
        (jnp.broadcast_to(lam_r, shape), jnp.broadcast_to(lam_i, shape), x_r, x_i), axis=0)
    y = (jnp.einsum('tngp,ghp->tngh', s_r, lw['c_re'].astype(f32))
         - jnp.einsum('tngp,ghp->tngh', s_i, lw['c_im'].astype(f32)))
    y = y + lw['d'].astype(f32).reshape(SSM_GROUPS, SSM_GROUP) * ug
    y = jnp.swapaxes(y, 0, 1).reshape(n, t, SSM_WIDTH)
    g = jax.nn.gelu(y)
    out = g * jax.nn.sigmoid(g @ lw['w_glu'].astype(f32) + lw['b_glu'].astype(f32))
    return out.astype(u.dtype), jnp.stack([s_r[-1], s_i[-1]], axis=-1)


def banded_attention(q, k, v, sink):
    n, l, hq, dh = q.shape
    hkv = k.shape[2]
    grp = hq // hkv
    nb = -(-l // BAND)
    padw = ((0, 0), (0, nb * BAND - l), (0, 0), (0, 0))
    q, k, v = jnp.pad(q, padw), jnp.pad(k, padw), jnp.pad(v, padw)
    qb = q.reshape(n, nb, BAND, hkv, grp, dh)

    def prev_and_cur(a):
        ab = a.reshape(n, nb, BAND, hkv, dh)
        prev = jnp.concatenate([jnp.zeros_like(ab[:, :1]), ab[:, :-1]], axis=1)
        return jnp.concatenate([prev, ab], axis=2)

    kb, vb = prev_and_cur(k), prev_and_cur(v)
    s = jnp.einsum('nbqhgd,nbkhd->nbhgqk', qb, kb, preferred_element_type=jnp.float32) * (dh ** -0.5)
    qi = jnp.arange(BAND)[:, None]
    kj = jnp.arange(2 * BAND)[None, :]
    dist = qi + BAND - kj
    kpos = (jnp.arange(nb)[:, None, None] - 1) * BAND + kj[None]
    mask = ((dist >= 0) & (dist <= BAND))[None] & (kpos >= 0)
    s = jnp.where(mask[None, :, None, None], s, -jnp.inf)
    lse = jax.nn.logsumexp(s, axis=-1)
    if sink is not None:
        lse = jnp.logaddexp(lse, sink.astype(jnp.float32).reshape(hkv, grp, 1))
    p = jnp.exp(s - lse[..., None]).astype(v.dtype)
    o = jnp.einsum('nbhgqk,nbkhd->nbqhgd', p, vb).reshape(n, nb * BAND, hq, dh)[:, :l]
    lse = lse.transpose(0, 1, 4, 2, 3).reshape(n, nb * BAND, hq)[:, :l]
    return o, lse


def gathered_attention(q, k_all, v_all, idx, valid, sink):
    n, t, hq, dh = q.shape
    hkv = k_all.shape[2]
    grp = hq // hkv
    kg, vg = k_all[:, idx], v_all[:, idx]
    qg = q.reshape(n, t, hkv, grp, dh)
    s = jnp.einsum('nthgd,ntkhd->nthgk', qg, kg, preferred_element_type=jnp.float32) * (dh ** -0.5)
    s = jnp.where(valid[None, :, None, None, :], s, -jnp.inf)
    lse = jax.nn.logsumexp(s, axis=-1)
    if sink is not None:
        lse = jnp.logaddexp(lse, sink.astype(jnp.float32).reshape(hkv, grp))
    p = jnp.exp(s - lse[..., None]).astype(v_all.dtype)
    o = jnp.einsum('nthgk,ntkhd->nthgd', p, vg).reshape(n, t, hq, dh)
    return o, lse.reshape(n, t, hq)


def window_index(window, dilation, buf_len, n_new):
    offs = jnp.arange(window // dilation + 1) * dilation
    idx = buf_len + jnp.arange(n_new)[:, None] - offs[None, :]
    return jnp.maximum(idx, 0), idx >= 0


def to_strided(a, d):
    n, l = a.shape[:2]
    rest = a.shape[2:]
    return jnp.swapaxes(a.reshape(n, l // d, d, *rest), 1, 2).reshape(n * d, l // d, *rest)


def from_strided(a, d, n):
    ld = a.shape[1]
    rest = a.shape[2:]
    return jnp.swapaxes(a.reshape(n, d, ld, *rest), 1, 2).reshape(n, ld * d, *rest)


def token_mixer(h, lw, cache):
    n, t, _ = h.shape
    z = jnp.einsum('btd,de->bte', h, lw['w_in'])
    offs = [int(o) for o in np.cumsum(SPLITS)[:-1]]
    pieces = jnp.split(z, offs, axis=-1)
    u = pieces[0]
    g_a, g_b, g_c = pieces[-N_BRANCH:]
    heads = lambda a: a.reshape(n, t, -1, HEAD_DIM)
    q_s, k_s, v_s = heads(pieces[1]), heads(pieces[2]), heads(pieces[3])

    h0 = jnp.zeros((n, SSM_GROUPS, SSM_STATE, 2), jnp.float32) if cache is None else cache['ssm']
    o_a, ssm_new = ssm_branch(u, h0, lw)

    if cache is None:
        o_b, _ = banded_attention(q_s, k_s, v_s, lw['sinks'])
        keep = min(SWA_WINDOW, t)
        swa_new = jnp.stack([k_s[:, t - keep:], v_s[:, t - keep:]], axis=2)
    else:
        buf = cache['swa']
        idx, valid = window_index(SWA_WINDOW, 1, buf.shape[1], t)
        o_b, _ = gathered_attention(q_s, jnp.concatenate([buf[:, :, 0], k_s], axis=1),
                                    jnp.concatenate([buf[:, :, 1], v_s], axis=1), idx, valid, lw['sinks'])
        swa_new = jnp.stack([k_s, v_s], axis=2)

    outs, lses, dil_new = [], [], []
    for gi, (win, dil) in enumerate(DIL_PAIRS):
        q_d, k_d, v_d = (heads(a) for a in pieces[4 + 3 * gi: 7 + 3 * gi])
        if cache is None:
            o, lse = banded_attention(to_strided(q_d, dil), to_strided(k_d, dil), to_strided(v_d, dil), None)
            o, lse = from_strided(o, dil, n), from_strided(lse, dil, n)
            keep = min(win, t)
            dil_new.append(jnp.stack([k_d[:, t - keep:], v_d[:, t - keep:]], axis=2))
        else:
            buf = cache['dil'][gi]
            idx, valid = window_index(win, dil, buf.shape[1], t)
            o, lse = gathered_attention(q_d, jnp.concatenate([buf[:, :, 0], k_d], axis=1),
                                        jnp.concatenate([buf[:, :, 1], v_d], axis=1), idx, valid, None)
            dil_new.append(jnp.stack([k_d, v_d], axis=2))
        outs.append(o)
        lses.append(lse)
    w = jax.nn.softmax(jnp.stack(lses), axis=0)[..., None]
    o_c = jnp.sum(w * jnp.stack(outs).astype(jnp.float32), axis=0).astype(h.dtype)

    y_a = o_a @ lw['w_branch_a']
    y_b = o_b.reshape(n, t, SWA_Q_W) @ lw['w_branch_b']
    y_c = o_c.reshape(n, t, DIL_W) @ lw['w_branch_c']
    merged = jax.nn.sigmoid(g_a) * y_a + jax.nn.sigmoid(g_b) * y_b + jax.nn.sigmoid(g_c) * y_c
    return merged @ lw['w_out'], (swa_new, dil_new[0], dil_new[1], dil_new[2], ssm_new)


def decoder_layer(x, p_l, lw, cache):
    mix, st = token_mixer(rmsnorm(x, lw['g_mix']), lw, cache)
    x = x + mix
    hm = rmsnorm(x, lw['g_mlp'])
    x = x + jnp.square(jax.nn.relu(hm @ lw['w_up'])) @ lw['w_down']
    gate = jax.nn.sigmoid(rmsnorm(x, lw['g_ple']) @ lw['w_ple_gate'])
    x = x + gate * (p_l @ lw['w_ple_proj'])
    return x, st


def setup_inputs(seed: int = 0) -> dict:
    key = jax.random.key(seed)
    ks = jax.random.split(key, 40)
    f32 = jnp.float32
    nrm = lambda i, shape, scale: scale * jax.random.normal(ks[i], shape, f32)
    L = DEPTH
    G, P, H = SSM_GROUPS, SSM_STATE, SSM_GROUP
    kv_shape = lambda win, nh: (L, DEC_BATCH, min(win, PAST_LEN), 2, nh, HEAD_DIM)
    return {
        'x_prompt': nrm(0, (BATCH, SEQ, D_MODEL), 1.0),
        'x_sample': nrm(1, (DEC_BATCH, DEC_SEQ, D_MODEL), 1.0),
        'cache_swa_kv': nrm(2, kv_shape(SWA_WINDOW, SWA_KV_HEADS), 1.0),
        'cache_dil_d1_kv': nrm(3, kv_shape(DIL_PAIRS[0][0], DIL_HEADS), 1.0),
        'cache_dil_d4_kv': nrm(4, kv_shape(DIL_PAIRS[1][0], DIL_HEADS), 1.0),
        'cache_dil_d16_kv': nrm(5, kv_shape(DIL_PAIRS[2][0], DIL_HEADS), 1.0),
        'state_ssm': nrm(6, (L, DEC_BATCH, G, P, 2), 0.1),
        'p_prompt': nrm(7, (L, BATCH, SEQ, PLE_DIM), 1.0),
        'p_sample': nrm(8, (L, DEC_BATCH, DEC_SEQ, PLE_DIM), 1.0),
        'w_in': nrm(9, (L, D_MODEL, D_IN), D_MODEL ** -0.5),
        'g_mix': 1.0 + nrm(10, (L, D_MODEL), 0.01),
        'ssm_a_re': -0.5 + nrm(11, (L, G, P), 0.01),
        'ssm_a_im': jnp.pi * jnp.arange(P, dtype=f32) + nrm(12, (L, G, P), 0.01),
        'ssm_log_dt': jax.random.uniform(ks[13], (L, G), f32, math.log(1e-3), math.log(1e-1)),
        'ssm_b_re': nrm(14, (L, G, P, H), (2 * H) ** -0.5),
        'ssm_b_im': nrm(15, (L, G, P, H), (2 * H) ** -0.5),
        'ssm_c_re': nrm(16, (L, G, H, P), P ** -0.5),
        'ssm_c_im': nrm(17, (L, G, H, P), P ** -0.5),
        'ssm_d': nrm(18, (L, SSM_WIDTH), 1.0),
        'w_glu': nrm(19, (L, SSM_WIDTH, SSM_WIDTH), SSM_WIDTH ** -0.5),
        'b_glu': nrm(20, (L, SSM_WIDTH), 0.01),
        'attn_sinks': nrm(21, (L, SWA_Q_HEADS), 0.5),
        'w_branch_a': nrm(22, (L, SSM_WIDTH, D_MODEL), SSM_WIDTH ** -0.5),
        'w_branch_b': nrm(23, (L, SWA_Q_W, D_MODEL), SWA_Q_W ** -0.5),
        'w_branch_c': nrm(24, (L, DIL_W, D_MODEL), DIL_W ** -0.5),
        'w_out': nrm(25, (L, D_MODEL, D_MODEL), D_MODEL ** -0.5),
        'g_mlp': 1.0 + nrm(26, (L, D_MODEL), 0.01),
        'w_up': nrm(27, (L, D_MODEL, D_FF), D_MODEL ** -0.5),
        'w_down': nrm(28, (L, D_FF, D_MODEL), D_FF ** -0.5),
        'g_ple': 1.0 + nrm(29, (L, D_MODEL), 0.01),
        'w_ple_gate': nrm(30, (L, D_MODEL, D_MODEL), D_MODEL ** -0.5),
        'w_ple_proj': nrm(31, (L, PLE_DIM, D_MODEL), PLE_DIM ** -0.5),
        'g_final': 1.0 + nrm(32, (D_MODEL,), 0.01),
    }


def reference(x_prompt, x_sample, cache_swa_kv, cache_dil_d1_kv, cache_dil_d4_kv, cache_dil_d16_kv, state_ssm,
              p_prompt, p_sample, w_in, g_mix, ssm_a_re, ssm_a_im, ssm_log_dt, ssm_b_re, ssm_b_im, ssm_c_re,
              ssm_c_im, ssm_d, w_glu, b_glu, attn_sinks, w_branch_a, w_branch_b, w_branch_c, w_out, g_mlp,
              w_up, w_down, g_ple, w_ple_gate, w_ple_proj, g_final):
    yp, ys = x_prompt, x_sample
    st_p, st_s = [], []
    for l in range(DEPTH):
        lw = {'w_in': w_in[l], 'g_mix': g_mix[l], 'a_re': ssm_a_re[l], 'a_im': ssm_a_im[l],
              'log_dt': ssm_log_dt[l], 'b_re': ssm_b_re[l], 'b_im': ssm_b_im[l], 'c_re': ssm_c_re[l],
              'c_im': ssm_c_im[l], 'd': ssm_d[l], 'w_glu': w_glu[l], 'b_glu': b_glu[l], 'sinks': attn_sinks[l],
              'w_branch_a': w_branch_a[l], 'w_branch_b': w_branch_b[l], 'w_branch_c': w_branch_c[l],
              'w_out': w_out[l], 'g_mlp': g_mlp[l], 'w_up': w_up[l], 'w_down': w_down[l], 'g_ple': g_ple[l],
              'w_ple_gate': w_ple_gate[l], 'w_ple_proj': w_ple_proj[l]}
        cache_l = {'swa': cache_swa_kv[l],
                   'dil': (cache_dil_d1_kv[l], cache_dil_d4_kv[l], cache_dil_d16_kv[l]),
                   'ssm': state_ssm[l]}
        yp, sp = decoder_layer(yp, p_prompt[l], lw, None)
        ys, ss = decoder_layer(ys, p_sample[l], lw, cache_l)
        st_p.append(sp)
        st_s.append(ss)
    yp = rmsnorm(yp, g_final)
    ys = rmsnorm(ys, g_final)
    stk = lambda sts, i: jnp.stack([s[i] for s in sts])
    return (yp, ys,
            stk(st_p, 0), stk(st_p, 1), stk(st_p, 2), stk(st_p, 3), stk(st_p, 4),
            stk(st_s, 0), stk(st_s, 1), stk(st_s, 2), stk(st_s, 3), stk(st_s, 4))
```

```cpp
#include <hip/hip_runtime.h>
#include <cstdio>
#include <cstdint>

#ifndef MK_ONE_LAUNCH
#define MK_ONE_LAUNCH 1
#endif
#ifndef REPS
#define REPS 0
#endif

#define LAS __attribute__((address_space(3)))
#define GAS __attribute__((address_space(1)))
typedef unsigned short bf16_t;
typedef short bf16x8 __attribute__((ext_vector_type(8)));
typedef short s16x4 __attribute__((ext_vector_type(4)));
typedef float f32x4 __attribute__((ext_vector_type(4)));
typedef float f32x2 __attribute__((ext_vector_type(2)));
typedef float f32x16 __attribute__((ext_vector_type(16)));
typedef unsigned u32x4 __attribute__((ext_vector_type(4)));
typedef unsigned u32x2 __attribute__((ext_vector_type(2)));
typedef __bf16 bf16x2_t __attribute__((ext_vector_type(2)));

constexpr int D = 1024, NBATCH = 8, SEQ = 4096, MP = NBATCH * SEQ  , MS = 128  , MT = MP + MS, MTP = 33024;
constexpr int DIN = 6656, DFF = 4096, PLE = 256, NLAYER = 2;
constexpr int ZC_U = 0, ZC_QS = 512, ZC_KS = 1024, ZC_VS = 1152, ZC_DIL = 1280, ZC_GATE = 3584;
constexpr int OBR_LD = 1280;
constexpr int XLD = 1280;
constexpr float EPS = 1e-6f;
constexpr float LOG2E = 1.4426950408889634f, LN2 = 0.6931471805599453f;
constexpr float SCL2 = 0.125f * LOG2E;

constexpr size_t O_YP = 0, O_YS = O_YP + (size_t)MP * D, O_SWAP = O_YS + (size_t)MS * D, O_D1P = O_SWAP + 2ull * 8 * 128 * 256, O_D4P = O_D1P + 2ull * 8 * 128 * 512,
                 O_D16P = O_D4P + 2ull * 8 * 512 * 512, O_SSMP = O_D16P + 2ull * 8 * 2048 * 512, O_SWAS = O_SSMP + 2ull * 8 * 32 * 64 * 2, O_D1S = O_SWAS + 2ull * 128 * 256,
                 O_D4S = O_D1S + 2ull * 128 * 512, O_D16S = O_D4S + 2ull * 128 * 512, O_SSMS = O_D16S + 2ull * 128 * 512, O_END = O_SSMS + 2ull * 128 * 32 * 64 * 2;

constexpr size_t al(size_t x) { return (x + 4095) & ~(size_t)4095; }
constexpr size_t WS_CTL = 0, CTL_BYTES = 65536;
constexpr size_t WO_IN = 0, WO_GLU = WO_IN + (size_t)DIN * D, WO_BR = WO_GLU + 512 * 512  , WO_OUT = WO_BR + 1024 * 1280,
                 WO_UP = WO_OUT + 1024 * 1024, WO_DOWN = WO_UP + (size_t)DFF * D, WO_PGP = WO_DOWN + (size_t)D * DFF  , WL_ELEMS = WO_PGP + 1024 * 1280;
constexpr size_t WS_W = al(WS_CTL + CTL_BYTES), WL_BYTES = al(WL_ELEMS * 2);
constexpr size_t SO_KT = 0  , SO_GT = SO_KT + 32 * 4096 * 2  , SO_F = SO_GT + 32 * 16 * 16 * 128 * 2  ,
                 SO_LAM16 = SO_F + 32 * 128 * 256 * 2  , SO_LAM = SO_LAM16 + 32 * 64 * 2 * 4  , SO_BB = SO_LAM + 32 * 64 * 2 * 4  ,
                 SL_BYTES = al(SO_BB + 32 * 64 * 16 * 2 * 4);
constexpr size_t WS_SSM = WS_W + NLAYER * WL_BYTES;
constexpr size_t WS_XB0 = WS_SSM + NLAYER * SL_BYTES, XB_BYTES = al((size_t)MTP * XLD * 2);
constexpr size_t WS_XB1 = WS_XB0 + XB_BYTES;
constexpr size_t WS_SSQ0 = WS_XB1 + XB_BYTES, SSQ_BYTES = al((size_t)MTP * 16 * 4);
constexpr size_t WS_SSQ1 = WS_SSQ0 + SSQ_BYTES;
constexpr size_t WS_Z = WS_SSQ1 + SSQ_BYTES;
constexpr size_t WS_OBR = WS_Z + al((size_t)MTP * DIN * 2);
constexpr size_t WS_ODIL = WS_OBR + al((size_t)MTP * OBR_LD * 2);
constexpr size_t WS_LSE = WS_ODIL + al(3ull * MTP * 256 * 2);
constexpr size_t WS_E = WS_LSE + al(3ull * MTP * 4 * 4);
constexpr size_t WS_SIN = WS_E + al(2048ull * 32 * 128 * 4);
constexpr size_t WS_GACT = WS_SIN + al(2048ull * 32 * 128 * 2);
constexpr size_t WS_MERGED = WS_GACT + al((size_t)MTP * 512 * 2);
constexpr size_t WS_HID = WS_MERGED + al((size_t)MTP * D * 2);
constexpr size_t WS_PP = WS_HID + al((size_t)MTP * DFF * 2);
constexpr size_t WS_END = WS_PP + al((size_t)MTP * D * 2);
constexpr size_t WS_XDUM = WS_END, WS_XBDUM = WS_XDUM + al((size_t)MTP * D * 4), WS_SSQDUM = WS_XBDUM + XB_BYTES, WS_END_PROBE = WS_SSQDUM + SSQ_BYTES;

__device__ __forceinline__ float bf2f(bf16_t b) { return __uint_as_float((unsigned)b << 16); }
__device__ __forceinline__ float bflo(unsigned w) { return __uint_as_float(w << 16); }
__device__ __forceinline__ float bfhi(unsigned w) { return __uint_as_float(w & 0xffff0000u); }
__device__ __forceinline__ unsigned pk2(float lo, float hi) { f32x2 v = {lo, hi}; bf16x2_t b = __builtin_convertvector(v, bf16x2_t); return __builtin_bit_cast(unsigned, b); }
__device__ __forceinline__ bf16_t f2bf(float f) { return (bf16_t)(pk2(f, 0.f) & 0xffffu); }
__device__ __forceinline__ u32x4 pack8(f32x4 a, f32x4 b) { u32x4 w; w.x = pk2(a[0], a[1]); w.y = pk2(a[2], a[3]); w.z = pk2(b[0], b[1]); w.w = pk2(b[2], b[3]); return w; }
__device__ __forceinline__ void unpack8(u32x4 w, f32x4& a, f32x4& b) { a = (f32x4){bflo(w.x), bfhi(w.x), bflo(w.y), bfhi(w.y)}; b = (f32x4){bflo(w.z), bfhi(w.z), bflo(w.w), bfhi(w.w)}; }
__device__ __forceinline__ float sigmoidf_(float x) { return __builtin_amdgcn_rcpf(1.f + __builtin_amdgcn_exp2f(-LOG2E * x)); }
__device__ __forceinline__ float gelu_tanh(float x) { const float u = 0.7978845608028654f * (x + 0.044715f * x * x * x); return x * __builtin_amdgcn_rcpf(1.f + __builtin_amdgcn_exp2f(-2.f * LOG2E * u)); }
__device__ __forceinline__ float wave_sum(float v) {
#pragma unroll
    for (int o = 1; o < 64; o <<= 1) v += __shfl_xor(v, o);
    return v;
}
#define LDS_WAIT() asm volatile("s_waitcnt lgkmcnt(0)" ::: "memory")
#define VM_WAIT() asm volatile("s_waitcnt vmcnt(0)" ::: "memory")

namespace pg8 {
constexpr int BM = 256, BK = 64, HALF = 128, HTB = HALF * BK * 2, STAGE_BYTES = 8 * HTB, NXCD = 8, WGM = 4;
__host__ __device__ __forceinline__ int lds_byte(int r, int c) { const int st = (r >> 4) * 2 + (c >> 5), rr = r & 15, cc = c & 31, ob = rr * 64 + cc * 2; return st * 1024 + (ob ^ (((ob >> 9) & 1) << 5)); }
__host__ __device__ __forceinline__ void stage_rc(int b, int& R, int& C) { const int st = b / 1024, sb = b % 1024, swz = sb ^ (((sb >> 9) & 1) << 5); R = (st >> 1) * 16 + swz / 64; C = (st & 1) * 32 + (swz % 64) / 2; }
__host__ __device__ __forceinline__ int perm32(int rho) { const int n = rho >> 4, i = rho & 15; return 8 * (i >> 2) + 4 * n + (i & 3); }
struct Unit { int pm, pn; };
struct Gemm { const bf16_t* A; const bf16_t* Bt; int M, N, K, lda, ldb; };
struct StaticOrder {
    int nM, nN, nwg, G, c;
    __host__ __device__ void init(int M, int N, int G_, int c_) { nM = M / BM; nN = N / BM; nwg = nM * nN; G = G_; c = c_; }
    __host__ __device__ bool next(int i, Unit& u) const {
        const long L = (long)i * G + c; if (L >= nwg) return false;
        int wgid = (int)L; { const int q = nwg / NXCD, r = nwg % NXCD, xcd = wgid % NXCD, off = wgid / NXCD; wgid = (xcd < r ? xcd * (q + 1) : r * (q + 1) + (xcd - r) * q) + off; }
        const int nig = WGM * nN, gid = wgid / nig, fm = gid * WGM, gsz = (nM - fm) < WGM ? (nM - fm) : WGM;
        u.pm = fm + ((wgid % nig) % gsz); u.pn = (wgid % nig) / gsz; return true;
    }
    __device__ __forceinline__ void a_ready(const Unit&) const {}
    __device__ __forceinline__ void done(const Unit&) const {}
};

template <class Epi, class Sched, bool ALIGN_EPI = false, bool SP2 = false>
__device__ __forceinline__ void gemm_phase(LAS unsigned char* lds, const Gemm g, const Sched& S, const Epi& E) {
    int tid_ = threadIdx.x; asm volatile("" : "+v"(tid_));
    const int tid = tid_, wid = __builtin_amdgcn_readfirstlane(tid >> 6), lane = tid & 63, wr = wid >> 2, wc = wid & 3, fr = lane & 15, fq = lane >> 4;
    const int K = g.K, nt = K / BK, lda = g.lda, ldb = g.ldb;
    unsigned voffA[2], voffB[2];
#pragma unroll
    for (int i = 0; i < 2; ++i) { int R, C; stage_rc(tid * 16 + i * 8192, R, C); const int Rb = Epi::PERM ? ((R & ~31) + perm32(R & 31)) : R;
        voffA[i] = (unsigned)(R * lda + C) * 2u; voffB[i] = (unsigned)(Rb * ldb + C) * 2u; }
    const size_t kstep = (size_t)(BK * 2);
    const size_t hstepA = (size_t)HALF * lda * 2, hstepB = (size_t)HALF * ldb * 2;
    const size_t tstepA = 2 * hstepA, tstepB = 2 * hstepB;
    const unsigned ldsw = (unsigned)wid * 1024u;
    const int aoff = lds_byte(wr * 64 + fr, fq * 8), boff = lds_byte(wc * 32 + fr, fq * 8);
#define PG8_SA(b, h) (((b) * 2 + (h)) * HTB)
#define PG8_SB(b, h) ((4 + (b) * 2 + (h)) * HTB)
#define PG8_STAGE(bufoff, gbase, voff) do { _Pragma("unroll") for (int _i = 0; _i < 2; ++_i) \
        __builtin_amdgcn_global_load_lds((const unsigned*)((const char*)(gbase) + (voff)[_i]), (LAS unsigned*)(lds + (bufoff) + ldsw + _i * 8192), 16, 0, 0); } while (0)
#define PG8_LDA(dst, b, h) do { _Pragma("unroll") for (int m = 0; m < 4; ++m) _Pragma("unroll") for (int k = 0; k < 2; ++k) dst[m][k] = *(const LAS bf16x8*)(lds + PG8_SA(b, h) + aoff + m * 2048 + k * 1024); } while (0)
#define PG8_LDB(dst, b, h) do { _Pragma("unroll") for (int n = 0; n < 2; ++n) _Pragma("unroll") for (int k = 0; k < 2; ++k) dst[n][k] = *(const LAS bf16x8*)(lds + PG8_SB(b, h) + boff + n * 2048 + k * 1024); } while (0)
#define PG8_MMA(ai, bj, At, Bt) do { __builtin_amdgcn_s_setprio(1); _Pragma("unroll") for (int m = 0; m < 4; ++m) _Pragma("unroll") for (int n = 0; n < 2; ++n) _Pragma("unroll") for (int k = 0; k < 2; ++k) \
        acc[ai][bj][m][n] = __builtin_amdgcn_mfma_f32_16x16x32_bf16(Bt[n][k], At[m][k], acc[ai][bj][m][n], 0, 0, 0); __builtin_amdgcn_s_setprio(0); } while (0)
#define PG8_WAIT_V(n) asm volatile("s_waitcnt vmcnt(" #n ")" ::: "memory")
#define PG8_WAIT_L(n) asm volatile("s_waitcnt lgkmcnt(" #n ")" ::: "memory")
#define PG8_BAR __builtin_amdgcn_s_barrier()
#define PG8_SCHED __builtin_amdgcn_sched_barrier(0)
    Unit cur, nxt; int ui = 0;
    if (!S.next(0, cur)) return;
    f32x4 acc[2][2][4][2];
#pragma unroll
    for (int a = 0; a < 2; ++a)
#pragma unroll
        for (int b = 0; b < 2; ++b)
#pragma unroll
            for (int m = 0; m < 4; ++m)
#pragma unroll
                for (int n = 0; n < 2; ++n) acc[a][b][m][n] = (f32x4){0.f, 0.f, 0.f, 0.f};
    bf16x8 At[4][2], B0[2][2], B1[2][2];
    const char* cA = (const char*)g.A + (size_t)cur.pm * tstepA; const char* cB = (const char*)g.Bt + (size_t)cur.pn * tstepB;
    S.a_ready(cur);
    if constexpr (SP2) {
        PG8_STAGE(PG8_SB(0, 0), cB, voffB); PG8_STAGE(PG8_SB(0, 1), cB + hstepB, voffB); PG8_STAGE(PG8_SA(0, 0), cA, voffA); PG8_STAGE(PG8_SA(0, 1), cA + hstepA, voffA);
        if (wr == 1) PG8_BAR;
        PG8_WAIT_V(2); PG8_BAR;
        PG8_STAGE(PG8_SB(1, 0), cB + kstep, voffB); PG8_STAGE(PG8_SA(1, 0), cA + kstep, voffA); PG8_STAGE(PG8_SB(1, 1), cB + hstepB + kstep, voffB);
        PG8_WAIT_V(6); PG8_BAR;
    } else {
        PG8_STAGE(PG8_SB(0, 0), cB, voffB); PG8_STAGE(PG8_SA(0, 0), cA, voffA); PG8_STAGE(PG8_SB(0, 1), cB + hstepB, voffB); PG8_STAGE(PG8_SA(0, 1), cA + hstepA, voffA);
        if (wr == 1) PG8_BAR;
        PG8_WAIT_V(4); PG8_BAR;
        PG8_STAGE(PG8_SB(1, 0), cB + kstep, voffB); PG8_STAGE(PG8_SA(1, 0), cA + kstep, voffA); PG8_STAGE(PG8_SB(1, 1), cB + hstepB + kstep, voffB);
        PG8_WAIT_V(6); PG8_BAR;
    }
    for (;;) {
        const bool has_next = S.next(ui + 1, nxt);
        const char* nA = has_next ? (const char*)g.A + (size_t)nxt.pm * tstepA : cA; const char* nB = has_next ? (const char*)g.Bt + (size_t)nxt.pn * tstepB : cB;
        for (int t = 0; t < nt; t += 2) {
            if constexpr (Epi::FLUSH) { if (E.is_flush(t)) { if constexpr (ALIGN_EPI) { if (wr == 0) PG8_BAR; }
                Unit uu = cur; { int oz = 0; asm volatile("" : "+s"(oz)); uu.pm += oz; }
                E.flush(acc, uu, t, wr, wc, fr, fq);
                if constexpr (!Epi::KEEP) {
#pragma unroll
                for (int a = 0; a < 2; ++a)
#pragma unroll
                    for (int b = 0; b < 2; ++b)
#pragma unroll
                        for (int m = 0; m < 4; ++m)
#pragma unroll
                            for (int n = 0; n < 2; ++n) acc[a][b][m][n] = (f32x4){0.f, 0.f, 0.f, 0.f}; }
                if constexpr (ALIGN_EPI) { if (wr == 1) PG8_BAR; } } }
            const bool last = (t == nt - 2);
            const char* a1 = cA + (size_t)(t + 1) * kstep;
            const char* a2 = last ? nA : cA + (size_t)(t + 2) * kstep; const char* b2 = last ? nB : cB + (size_t)(t + 2) * kstep;
            const char* a3 = a2 + kstep; const char* b3 = b2 + kstep;
            if (last && has_next) S.a_ready(nxt);
            if constexpr (SP2) {
            PG8_LDB(B0, 0, 0); PG8_LDB(B1, 0, 1); PG8_SCHED; PG8_LDA(At, 0, 0); PG8_STAGE(PG8_SA(1, 1), a1 + hstepA, voffA);
            PG8_WAIT_V(8); PG8_WAIT_L(0); PG8_BAR; PG8_MMA(0, 0, At, B0); PG8_MMA(0, 1, At, B1); PG8_BAR; PG8_SCHED;
            PG8_LDA(At, 0, 1); PG8_STAGE(PG8_SB(0, 0), b2, voffB); PG8_STAGE(PG8_SB(0, 1), b2 + hstepB, voffB); PG8_STAGE(PG8_SA(0, 0), a2, voffA);
            PG8_WAIT_V(8); PG8_WAIT_L(0); PG8_BAR; PG8_MMA(1, 0, At, B0); PG8_MMA(1, 1, At, B1); PG8_BAR; PG8_SCHED;
            PG8_LDB(B0, 1, 0); PG8_LDB(B1, 1, 1); PG8_SCHED; PG8_LDA(At, 1, 0); PG8_STAGE(PG8_SA(0, 1), a2 + hstepA, voffA);
            PG8_WAIT_V(8); PG8_WAIT_L(0); PG8_BAR; PG8_MMA(0, 0, At, B0); PG8_MMA(0, 1, At, B1); PG8_BAR; PG8_SCHED;
            PG8_LDA(At, 1, 1); PG8_STAGE(PG8_SB(1, 0), b3, voffB); PG8_STAGE(PG8_SB(1, 1), b3 + hstepB, voffB); PG8_STAGE(PG8_SA(1, 0), a3, voffA);
            PG8_WAIT_V(8); PG8_WAIT_L(0); PG8_BAR; PG8_MMA(1, 0, At, B0); PG8_MMA(1, 1, At, B1); PG8_BAR; PG8_SCHED;
            } else {
            PG8_LDB(B0, 0, 0); PG8_SCHED; PG8_LDA(At, 0, 0); PG8_STAGE(PG8_SA(1, 1), a1 + hstepA, voffA);
            PG8_WAIT_L(8); PG8_BAR; PG8_WAIT_L(0); PG8_MMA(0, 0, At, B0); PG8_BAR; PG8_SCHED;
            PG8_LDB(B1, 0, 1); PG8_STAGE(PG8_SB(0, 0), b2, voffB);
            PG8_BAR; PG8_WAIT_L(0); PG8_MMA(0, 1, At, B1); PG8_BAR;
            PG8_LDA(At, 0, 1); PG8_STAGE(PG8_SA(0, 0), a2, voffA);
            PG8_BAR; PG8_WAIT_L(0); PG8_MMA(1, 0, At, B0); PG8_BAR; PG8_SCHED;
            PG8_STAGE(PG8_SB(0, 1), b2 + hstepB, voffB);
            PG8_WAIT_V(6); PG8_BAR; PG8_MMA(1, 1, At, B1); PG8_BAR;
            PG8_LDB(B0, 1, 0); PG8_SCHED; PG8_LDA(At, 1, 0); PG8_STAGE(PG8_SA(0, 1), a2 + hstepA, voffA);
            PG8_WAIT_L(8); PG8_BAR; PG8_WAIT_L(0); PG8_MMA(0, 0, At, B0); PG8_BAR; PG8_SCHED;
            PG8_LDB(B1, 1, 1); PG8_STAGE(PG8_SB(1, 0), b3, voffB);
            PG8_BAR; PG8_WAIT_L(0); PG8_MMA(0, 1, At, B1); PG8_BAR;
            PG8_LDA(At, 1, 1); PG8_STAGE(PG8_SA(1, 0), a3, voffA);
            PG8_BAR; PG8_WAIT_L(0); PG8_MMA(1, 0, At, B0); PG8_BAR; PG8_SCHED;
            PG8_STAGE(PG8_SB(1, 1), b3 + hstepB, voffB);
            PG8_WAIT_V(6); PG8_BAR; PG8_MMA(1, 1, At, B1); PG8_BAR;
            }
        }
        if constexpr (ALIGN_EPI) { if (wr == 0) PG8_BAR; }
        E(acc, cur, wr, wc, fr, fq); S.done(cur);
        if (!has_next) break;
#pragma unroll
        for (int a = 0; a < 2; ++a)
#pragma unroll
            for (int b = 0; b < 2; ++b)
#pragma unroll
                for (int m = 0; m < 4; ++m)
#pragma unroll
                    for (int n = 0; n < 2; ++n) acc[a][b][m][n] = (f32x4){0.f, 0.f, 0.f, 0.f};
        cur = nxt; cA = nA; cB = nB; ++ui;
        if constexpr (ALIGN_EPI) { if (wr == 1) PG8_BAR; }
    }
    PG8_WAIT_V(0);
    if constexpr (!ALIGN_EPI) { if (wr == 0) PG8_BAR; }
    PG8_BAR;
#undef PG8_SA
#undef PG8_SB
#undef PG8_STAGE
#undef PG8_LDA
#undef PG8_LDB
#undef PG8_MMA
#undef PG8_WAIT_V
#undef PG8_WAIT_L
#undef PG8_BAR
#undef PG8_SCHED
}
}

__device__ __forceinline__ float row_rstd(const float* ssq, int row, int fq) {
    const f32x4 p = *(const f32x4*)(ssq + (size_t)row * 16 + 4 * fq);
    float s = (p[0] + p[1]) + (p[2] + p[3]);
    s += __shfl_xor(s, 16); s += __shfl_xor(s, 32);
    return rsqrtf(s * (1.f / D) + EPS);
}
struct FWin { static constexpr bool FLUSH = false, KEEP = false; const float* ssq; bf16_t* z;
    __device__ __forceinline__ float ctx(int row, int fq) const { return row_rstd(ssq, row, fq); }
    __device__ __forceinline__ void operator()(int row, int col, float rs, f32x4 v0, f32x4 v1) const { __builtin_nontemporal_store(pack8(v0 * rs, v1 * rs), (u32x4*)(z + (size_t)row * DIN + col)); } };
struct FGlu { static constexpr bool FLUSH = false, KEEP = false; const bf16_t* gact; const float* bias; bf16_t* obr;
    __device__ __forceinline__ float ctx(int, int) const { return 0.f; }
    __device__ __forceinline__ void operator()(int row, int col, float, f32x4 v0, f32x4 v1) const {
        f32x4 g0, g1; unpack8(*(const u32x4*)(gact + (size_t)row * 512 + col), g0, g1);
        const f32x4 b0 = *(const f32x4*)(bias + col), b1 = *(const f32x4*)(bias + col + 4);
#pragma unroll
        for (int i = 0; i < 4; ++i) { g0[i] *= sigmoidf_(v0[i] + b0[i]); g1[i] *= sigmoidf_(v1[i] + b1[i]); }
        *(u32x4*)(obr + (size_t)row * OBR_LD + col) = pack8(g0, g1); } };
template <bool FIRST> struct FBranch { static constexpr bool FLUSH = false, KEEP = false; const bf16_t* zgate; bf16_t* merged;
    __device__ __forceinline__ float ctx(int, int) const { return 0.f; }
    __device__ __forceinline__ void operator()(int row, int col, float, f32x4 v0, f32x4 v1) const {
        f32x4 g0, g1; unpack8(*(const u32x4*)(zgate + (size_t)row * DIN + col), g0, g1);
        f32x4 m0 = {0.f, 0.f, 0.f, 0.f}, m1 = {0.f, 0.f, 0.f, 0.f};
        if (!FIRST) unpack8(*(const u32x4*)(merged + (size_t)row * D + col), m0, m1);
#pragma unroll
        for (int i = 0; i < 4; ++i) { m0[i] += sigmoidf_(g0[i]) * v0[i]; m1[i] += sigmoidf_(g1[i]) * v1[i]; }
        *(u32x4*)(merged + (size_t)row * D + col) = pack8(m0, m1); } };
struct FUp { static constexpr bool FLUSH = false, KEEP = false; const float* ssq; bf16_t* hid;
    __device__ __forceinline__ float ctx(int row, int fq) const { return row_rstd(ssq, row, fq); }
    __device__ __forceinline__ void operator()(int row, int col, float rs, f32x4 v0, f32x4 v1) const {
#pragma unroll
        for (int i = 0; i < 4; ++i) { float a = fmaxf(v0[i] * rs, 0.f), b = fmaxf(v1[i] * rs, 0.f); v0[i] = a * a; v1[i] = b * b; }
        __builtin_nontemporal_store(pack8(v0, v1), (u32x4*)(hid + (size_t)row * DFF + col)); } };
struct FPp { static constexpr bool FLUSH = false, KEEP = false; bf16_t* pp;
    __device__ __forceinline__ float ctx(int, int) const { return 0.f; }
    __device__ __forceinline__ void operator()(int row, int col, float, f32x4 v0, f32x4 v1) const { *(u32x4*)(pp + (size_t)row * D + col) = pack8(v0, v1); } };
__device__ __forceinline__ float sig_ratio(float gn, float gd) {
    gn = __builtin_amdgcn_fmed3f(gn, -30.f, 30.f); gd = __builtin_amdgcn_fmed3f(gd, -30.f, 30.f);
    return (1.f + __builtin_amdgcn_exp2f(-LOG2E * gd)) * __builtin_amdgcn_rcpf(1.f + __builtin_amdgcn_exp2f(-LOG2E * gn)); }
struct FBr { static constexpr bool FLUSH = true, KEEP = true; const bf16_t* z; bf16_t* merged;
    __device__ __forceinline__ float ctx(int, int) const { return 0.f; }
    __device__ __forceinline__ bool is_flush(int t) const { return t == 8 || t == 16; }
    __device__ __forceinline__ void flush(int t, int row, int col, float, f32x4& v0, f32x4& v1) const {
        const int gc = (t == 8) ? ZC_GATE : ZC_GATE + 1024;
        f32x4 n0, n1, d0, d1; unpack8(__builtin_nontemporal_load((const u32x4*)(z + (size_t)row * DIN + gc + col)), n0, n1); unpack8(*(const u32x4*)(z + (size_t)row * DIN + gc + 1024 + col), d0, d1);
#pragma unroll
        for (int i = 0; i < 4; ++i) { v0[i] *= sig_ratio(n0[i], d0[i]); v1[i] *= sig_ratio(n1[i], d1[i]); } }
    __device__ __forceinline__ void operator()(int row, int col, float, f32x4 v0, f32x4 v1) const {
        f32x4 g0, g1; unpack8(__builtin_nontemporal_load((const u32x4*)(z + (size_t)row * DIN + ZC_GATE + 2048 + col)), g0, g1);
#pragma unroll
        for (int i = 0; i < 4; ++i) { v0[i] *= sigmoidf_(g0[i]); v1[i] *= sigmoidf_(g1[i]); }
        *(u32x4*)(merged + (size_t)row * D + col) = pack8(v0, v1); } };
__device__ __forceinline__ float sumsq8(f32x4 a, f32x4 b) { return ((a[0] * a[0] + a[1] * a[1]) + (a[2] * a[2] + a[3] * a[3])) + ((b[0] * b[0] + b[1] * b[1]) + (b[2] * b[2] + b[3] * b[3])); }
struct FRes { static constexpr bool FLUSH = false, KEEP = false; const bf16_t* xin; bf16_t* xout;
    __device__ __forceinline__ float ctx(int, int) const { return 0.f; }
    __device__ __forceinline__ float operator()(int row, int col, float, f32x4 v0, f32x4 v1) const {
        f32x4 x0, x1; unpack8(*(const u32x4*)(xin + (size_t)row * XLD + col), x0, x1); x0 += v0; x1 += v1;
        *(u32x4*)(xout + (size_t)row * XLD + col) = pack8(x0, x1); return sumsq8(x0, x1); } };
struct FPg { static constexpr bool FLUSH = false, KEEP = false; const float* ssq; const bf16_t* pp; const bf16_t* xin; bf16_t* xout;
    __device__ __forceinline__ float ctx(int row, int fq) const { return row_rstd(ssq, row, fq); }
    __device__ __forceinline__ float operator()(int row, int col, float rs, f32x4 v0, f32x4 v1) const {
        f32x4 p0, p1, x0, x1; unpack8(*(const u32x4*)(pp + (size_t)row * D + col), p0, p1); unpack8(*(const u32x4*)(xin + (size_t)row * XLD + col), x0, x1);
#pragma unroll
        for (int i = 0; i < 4; ++i) { x0[i] += sigmoidf_(v0[i] * rs) * p0[i]; x1[i] += sigmoidf_(v1[i] * rs) * p1[i]; }
        *(u32x4*)(xout + (size_t)row * XLD + col) = pack8(x0, x1); return sumsq8(x0, x1); } };
struct FPgBig { static constexpr bool FLUSH = true, KEEP = false; const float* ssq; bf16_t* gb; const bf16_t* xin; bf16_t* xout;
    __device__ __forceinline__ float ctx(int row, int fq) const { return row_rstd(ssq, row, fq); }
    __device__ __forceinline__ bool is_flush(int t) const { return t == 16; }
    __device__ __forceinline__ void flush(int, int row, int col, float rs, f32x4& a0, f32x4& a1) const { f32x4 v0 = a0, v1 = a1;
#pragma unroll
        for (int i = 0; i < 4; ++i) { v0[i] = sigmoidf_(v0[i] * rs); v1[i] = sigmoidf_(v1[i] * rs); }
        *(u32x4*)(gb + (size_t)row * D + col) = pack8(v0, v1); }
    __device__ __forceinline__ float operator()(int row, int col, float, f32x4 v0, f32x4 v1) const {
        f32x4 g0, g1, x0, x1; unpack8(*(const u32x4*)(gb + (size_t)row * D + col), g0, g1); unpack8(*(const u32x4*)(xin + (size_t)row * XLD + col), x0, x1);
        x0 += g0 * v0; x1 += g1 * v1;
        *(u32x4*)(xout + (size_t)row * XLD + col) = pack8(x0, x1); return sumsq8(x0, x1); } };

template <class F> struct EpiP { static constexpr bool PERM = true, FLUSH = F::FLUSH, KEEP = F::KEEP; F f;
    template <bool FL, class ACC> __device__ __forceinline__ void run(ACC& acc, const pg8::Unit& u, int t, int wr, int wc, int fr, int fq) const {
#pragma unroll
        for (int ai = 0; ai < 2; ++ai)
#pragma unroll
            for (int m = 0; m < 4; ++m) { const int row = u.pm * 256 + ai * 128 + wr * 64 + m * 16 + fr; const float c = f.ctx(row, fq);
#pragma unroll
                for (int bj = 0; bj < 2; ++bj) { const int col = u.pn * 256 + bj * 128 + wc * 32 + 8 * fq;
                    if constexpr (FL) f.flush(t, row, col, c, acc[ai][bj][m][0], acc[ai][bj][m][1]); else f(row, col, c, acc[ai][bj][m][0], acc[ai][bj][m][1]); }
                if (m == 3) asm volatile("" ::: "memory"); } }
    __device__ __forceinline__ void operator()(const f32x4 (&acc)[2][2][4][2], const pg8::Unit& u, int wr, int wc, int fr, int fq) const { run<false>(acc, u, 0, wr, wc, fr, fq); }
    __device__ __forceinline__ bool is_flush(int t) const { return f.is_flush(t); }
    __device__ __forceinline__ void flush(f32x4 (&acc)[2][2][4][2], const pg8::Unit& u, int t, int wr, int wc, int fr, int fq) const { run<true>(acc, u, t, wr, wc, fr, fq); } };
template <class F> struct EpiR { static constexpr bool PERM = true, FLUSH = F::FLUSH, KEEP = F::KEEP; F f; float* ssq_out;
    template <bool FL, class ACC> __device__ __forceinline__ void run(ACC& acc, const pg8::Unit& u, int t, int wr, int wc, int fr, int fq) const {
#pragma unroll
        for (int ai = 0; ai < 2; ++ai)
#pragma unroll
            for (int m = 0; m < 4; ++m) { const int row = u.pm * 256 + ai * 128 + wr * 64 + m * 16 + fr; const float c = f.ctx(row, fq); float sq = 0.f;
#pragma unroll
                for (int bj = 0; bj < 2; ++bj) { const int col = u.pn * 256 + bj * 128 + wc * 32 + 8 * fq;
                    if constexpr (FL) f.flush(t, row, col, c, acc[ai][bj][m][0], acc[ai][bj][m][1]); else sq += f(row, col, c, acc[ai][bj][m][0], acc[ai][bj][m][1]); }
                if constexpr (!FL) { sq += __shfl_xor(sq, 16); sq += __shfl_xor(sq, 32);
                    if (fq == 0) ssq_out[(size_t)row * 16 + u.pn * 4 + wc] = sq; }
                if (m == 3) asm volatile("" ::: "memory"); } }
    __device__ __forceinline__ void operator()(const f32x4 (&acc)[2][2][4][2], const pg8::Unit& u, int wr, int wc, int fr, int fq) const { run<false>(acc, u, 0, wr, wc, fr, fq); }
    __device__ __forceinline__ bool is_flush(int t) const { return f.is_flush(t); }
    __device__ __forceinline__ void flush(f32x4 (&acc)[2][2][4][2], const pg8::Unit& u, int t, int wr, int wc, int fr, int fq) const { run<true>(acc, u, t, wr, wc, fr, fq); } };

template <bool RES, class F>
__device__ __forceinline__ void skinny_gemm(LAS unsigned char* lds, const bf16_t* A, int lda, const bf16_t* Bt, int ldb, int N, int K, const F& f, float* ssq_out, bool idem = false) {
    int tid_ = threadIdx.x; asm volatile("" : "+v"(tid_));
    const int tid = tid_, wid = __builtin_amdgcn_readfirstlane(tid >> 6), lane = tid & 63, fr = lane & 15, fq = lane >> 4;
    const int nunits = 8 * (N / 64), G = gridDim.x, kw = K / 8;
    LAS f32x4* part = (LAS f32x4*)lds;
    for (int rs = 0; rs < ((REPS && idem) ? 2 : 1); ++rs)
    for (int u = blockIdx.x; u < nunits; u += G) {
        const int rt = u & 7, cg = u >> 3, row0 = MP + 16 * rt, col0 = 64 * cg;
        const bf16_t* ap = A + (size_t)(row0 + fr) * lda + wid * kw + 8 * fq;
        const bf16_t* bp[4];
#pragma unroll
        for (int n = 0; n < 4; ++n) bp[n] = Bt + (size_t)(col0 + 32 * (n >> 1) + 8 * (fr >> 2) + 4 * (n & 1) + (fr & 3)) * ldb + wid * kw + 8 * fq;
        f32x4 acc[4];
#pragma unroll
        for (int n = 0; n < 4; ++n) acc[n] = (f32x4){0.f, 0.f, 0.f, 0.f};
#pragma unroll 4
        for (int k = 0; k < kw; k += 32) { const bf16x8 a = *(const bf16x8*)(ap + k);
#pragma unroll
            for (int n = 0; n < 4; ++n) acc[n] = __builtin_amdgcn_mfma_f32_16x16x32_bf16(*(const bf16x8*)(bp[n] + k), a, acc[n], 0, 0, 0); }
#pragma unroll
        for (int n = 0; n < 4; ++n) part[(wid * 4 + n) * 64 + lane] = acc[n];
        __syncthreads();
        if (wid == 0) {
#pragma unroll
            for (int n = 0; n < 4; ++n) { f32x4 s = part[n * 64 + lane];
#pragma unroll
                for (int w = 1; w < 8; ++w) s += part[(w * 4 + n) * 64 + lane];
                acc[n] = s; }
            const int row = row0 + fr; const float c = f.ctx(row, fq);
            if constexpr (RES) { float sq = 0.f;
#pragma unroll
                for (int gq = 0; gq < 2; ++gq) sq += f(row, col0 + 32 * gq + 8 * fq, c, acc[2 * gq], acc[2 * gq + 1]);
                sq += __shfl_xor(sq, 16); sq += __shfl_xor(sq, 32);
                if (fq == 0) ssq_out[(size_t)row * 16 + cg] = sq;
            } else {
#pragma unroll
                for (int gq = 0; gq < 2; ++gq) f(row, col0 + 32 * gq + 8 * fq, c, acc[2 * gq], acc[2 * gq + 1]);
            }
        }
        __syncthreads();
    }
}

__device__ __forceinline__ void attn_unit(const bf16_t* z, long rowbase, int dstride, int qt, int qcol, int kcol, int vcol, bf16_t* obase, int ldo, float* lsep,
                                          bool has_sink, float sink2, LAS unsigned char* wl, int lane) {
    const int r32 = lane & 31, hi = lane >> 5;
    const float NEG = -__builtin_inff();
    bf16x8 qf[4], kf[5][4];
    { const bf16_t* zq = z + (size_t)(rowbase + (long)(32 * qt + r32) * dstride) * DIN + qcol + 8 * hi;
#pragma unroll
      for (int s = 0; s < 4; ++s) qf[s] = *(const bf16x8*)(zq + 16 * s); }
#pragma unroll
    for (int j = 0; j < 5; ++j) { const int kt = (qt - 4 + j) < 0 ? 0 : (qt - 4 + j);
        const bf16_t* zk = z + (size_t)(rowbase + (long)(32 * kt + r32) * dstride) * DIN + kcol + 8 * hi;
#pragma unroll
        for (int s = 0; s < 4; ++s) kf[j][s] = *(const bf16x8*)(zk + 16 * s); }
    f32x16 S[5];
#pragma unroll
    for (int j = 0; j < 5; ++j) { f32x16 acc;
#pragma unroll
        for (int r = 0; r < 16; ++r) acc[r] = 0.f;
#pragma unroll
        for (int s = 0; s < 4; ++s) acc = __builtin_amdgcn_mfma_f32_32x32x16_bf16(kf[j][s], qf[s], acc, 0, 0, 0);
        S[j] = acc; }
    u32x4 vr[3][4];
    const bf16_t* zv = z + (size_t)(rowbase + (long)(lane >> 3) * dstride) * DIN + vcol + 8 * (lane & 7);
#define LOADV(j) do { const int kt_ = (qt - 4 + (j)) < 0 ? 0 : (qt - 4 + (j)); _Pragma("unroll") for (int i = 0; i < 4; ++i) vr[(j) % 3][i] = *(const u32x4*)(zv + (size_t)((long)(32 * kt_ + 8 * i) * dstride) * DIN); } while (0)
    LOADV(0); LOADV(1); LOADV(2);
    float m = NEG;
#pragma unroll
    for (int j = 0; j < 5; ++j) { const bool tv = (qt - 4 + j) >= 0;
#pragma unroll
        for (int r = 0; r < 16; ++r) { const int kk = (r & 3) + 8 * (r >> 2) + 4 * hi; float v = S[j][r];
            if (j == 0) v = (kk < r32) ? NEG : v;
            if (j == 4) v = (kk > r32) ? NEG : v;
            if (j < 4) v = tv ? v : NEG;
            S[j][r] = v; m = fmaxf(m, v); } }
    m = fmaxf(m, __shfl_xor(m, 32));
    float m2 = m * SCL2;
    if (has_sink) m2 = fmaxf(m2, sink2);
    float l = 0.f;
#pragma unroll
    for (int j = 0; j < 5; ++j)
#pragma unroll
        for (int r = 0; r < 16; ++r) { const float p = __builtin_amdgcn_exp2f(__builtin_fmaf(S[j][r], SCL2, -m2)); S[j][r] = p; l += p; }
    l += __shfl_xor(l, 32);
    if (has_sink) l += __builtin_amdgcn_exp2f(sink2 - m2);
    const float inv = 1.f / l;
    f32x16 O0, O1;
#pragma unroll
    for (int r = 0; r < 16; ++r) { O0[r] = 0.f; O1[r] = 0.f; }
    const int q4 = (lane & 15) >> 2, p4 = lane & 3, blk = (lane >> 4) & 1;
    const LAS unsigned char* trb = wl + (4 * hi + q4) * 144 + (16 * blk + 4 * p4) * 2;
#pragma unroll
    for (int j = 0; j < 5; ++j) {
#pragma unroll
        for (int i = 0; i < 4; ++i) { const int c = lane + 64 * i, key = c >> 3, cc = c & 7; *(LAS u32x4*)(wl + key * 144 + cc * 16) = vr[j % 3][i]; }
        if (j < 2) LOADV(j + 3);
#pragma unroll
        for (int s2 = 0; s2 < 2; ++s2) {
            u32x4 pw; pw.x = pk2(S[j][8 * s2 + 0] * inv, S[j][8 * s2 + 1] * inv); pw.y = pk2(S[j][8 * s2 + 2] * inv, S[j][8 * s2 + 3] * inv);
            pw.z = pk2(S[j][8 * s2 + 4] * inv, S[j][8 * s2 + 5] * inv); pw.w = pk2(S[j][8 * s2 + 6] * inv, S[j][8 * s2 + 7] * inv);
            const bf16x8 pa = __builtin_bit_cast(bf16x8, pw);
#pragma unroll
            for (int dh = 0; dh < 2; ++dh) {
                const s16x4 lo = __builtin_bit_cast(s16x4, __builtin_amdgcn_ds_read_tr16_b64_v4i16((LAS s16x4*)(trb + (16 * s2) * 144 + 64 * dh)));
                const s16x4 hh = __builtin_bit_cast(s16x4, __builtin_amdgcn_ds_read_tr16_b64_v4i16((LAS s16x4*)(trb + (16 * s2 + 8) * 144 + 64 * dh)));
                const bf16x8 vb = __builtin_shufflevector(lo, hh, 0, 1, 2, 3, 4, 5, 6, 7);
                if (dh == 0) O0 = __builtin_amdgcn_mfma_f32_32x32x16_bf16(pa, vb, O0, 0, 0, 0);
                else         O1 = __builtin_amdgcn_mfma_f32_32x32x16_bf16(pa, vb, O1, 0, 0, 0);
            }
        }
    }
#pragma unroll
    for (int r = 0; r < 16; ++r) { const int q = (r & 3) + 8 * (r >> 2) + 4 * hi;
        *(LAS bf16_t*)(wl + q * 144 + r32 * 2) = f2bf(O0[r]); *(LAS bf16_t*)(wl + q * 144 + 64 + r32 * 2) = f2bf(O1[r]); }
#pragma unroll
    for (int i = 0; i < 4; ++i) { const int c = lane + 64 * i, q = c >> 3, cc = c & 7;
        const u32x4 v = *(const LAS u32x4*)(wl + q * 144 + cc * 16);
        *(u32x4*)(obase + (size_t)(rowbase + (long)(32 * qt + q) * dstride) * ldo + 8 * cc) = v; }
    if (lsep && hi == 0) lsep[(size_t)(rowbase + (long)(32 * qt + r32) * dstride) * 4] = (m2 + __builtin_amdgcn_logf(l)) * LN2;
#undef LOADV
}

__device__ __forceinline__ void skinny_branches(LAS unsigned char* lds, const bf16_t* A  , const bf16_t* Bt  , const bf16_t* z, bf16_t* merged, int wave_) {
    int tid_ = threadIdx.x; asm volatile("" : "+v"(tid_)); (void)wave_;
    const int wid = __builtin_amdgcn_readfirstlane(tid_ >> 6), lane = tid_ & 63, fr = lane & 15, fq = lane >> 4;
    const int br = wid < 3 ? 0 : (wid < 6 ? 1 : 2), wi = wid - (br == 0 ? 0 : br == 1 ? 3 : 6);
    const int s0 = br == 2 ? 32 + 4 * wi : 16 * br + (wi == 0 ? 0 : wi == 1 ? 6 : 11), s1 = br == 2 ? s0 + 4 : 16 * br + (wi == 0 ? 6 : wi == 1 ? 11 : 16);
    LAS f32x4* part = (LAS f32x4*)lds;
    const int G = gridDim.x;
    for (int u = blockIdx.x; u < 8 * (D / 64); u += G) {
        const int rt = u & 7, cg = u >> 3, row0 = MP + 16 * rt, col0 = 64 * cg;
        const bf16_t* ap = A + (size_t)(row0 + fr) * OBR_LD + 8 * fq;
        const bf16_t* bp[4];
#pragma unroll
        for (int n = 0; n < 4; ++n) bp[n] = Bt + (size_t)(col0 + 32 * (n >> 1) + 8 * (fr >> 2) + 4 * (n & 1) + (fr & 3)) * 1280 + 8 * fq;
        f32x4 acc[4];
#pragma unroll
        for (int n = 0; n < 4; ++n) acc[n] = (f32x4){0.f, 0.f, 0.f, 0.f};
#pragma unroll 6
        for (int st = s0; st < s1; ++st) { const bf16x8 a = *(const bf16x8*)(ap + 32 * st);
#pragma unroll
            for (int n = 0; n < 4; ++n) acc[n] = __builtin_amdgcn_mfma_f32_16x16x32_bf16(*(const bf16x8*)(bp[n] + 32 * st), a, acc[n], 0, 0, 0); }
#pragma unroll
        for (int n = 0; n < 4; ++n) part[(wid * 4 + n) * 64 + lane] = acc[n];
        __syncthreads();
        if (wid == 0) { const int row = row0 + fr;
#pragma unroll
            for (int gq = 0; gq < 2; ++gq) { const int col = col0 + 32 * gq + 8 * fq; f32x4 m0 = {0.f, 0.f, 0.f, 0.f}, m1 = m0;
#pragma unroll
                for (int b3 = 0; b3 < 3; ++b3) { const int w0 = b3 == 0 ? 0 : b3 == 1 ? 3 : 6, nw = b3 == 2 ? 2 : 3;
                    f32x4 s0v = part[(w0 * 4 + 2 * gq) * 64 + lane], s1v = part[(w0 * 4 + 2 * gq + 1) * 64 + lane];
#pragma unroll
                    for (int w = 1; w < 3; ++w) if (w < nw) { s0v += part[((w0 + w) * 4 + 2 * gq) * 64 + lane]; s1v += part[((w0 + w) * 4 + 2 * gq + 1) * 64 + lane]; }
                    f32x4 g0, g1; unpack8(*(const u32x4*)(z + (size_t)row * DIN + ZC_GATE + 1024 * b3 + col), g0, g1);
#pragma unroll
                    for (int i = 0; i < 4; ++i) { m0[i] += sigmoidf_(g0[i]) * s0v[i]; m1[i] += sigmoidf_(g1[i]) * s1v[i]; } }
                *(u32x4*)(merged + (size_t)row * D + col) = pack8(m0, m1); }
        }
        __syncthreads();
    }
}

__device__ __forceinline__ void skinny_ple(LAS unsigned char* lds, const bf16_t* A  , const bf16_t* Bt  , const float* ssq, bf16_t* xout, float* ssq_out) {
    int tid_ = threadIdx.x; asm volatile("" : "+v"(tid_));
    const int wid = __builtin_amdgcn_readfirstlane(tid_ >> 6), lane = tid_ & 63, fr = lane & 15, fq = lane >> 4;
    const int s0 = wid < 4 ? 5 * wid : (wid < 7 ? 20 + 4 * (wid - 4) : 32), s1 = wid < 4 ? s0 + 5 : (wid < 7 ? s0 + 4 : 40);
    LAS f32x4* part = (LAS f32x4*)lds;
    const int G = gridDim.x;
    for (int u = blockIdx.x; u < 8 * (D / 64); u += G) {
        const int rt = u & 7, cg = u >> 3, row0 = MP + 16 * rt, col0 = 64 * cg;
        const bf16_t* ap = A + (size_t)(row0 + fr) * XLD + 8 * fq;
        const bf16_t* bp[4];
#pragma unroll
        for (int n = 0; n < 4; ++n) bp[n] = Bt + (size_t)(col0 + 32 * (n >> 1) + 8 * (fr >> 2) + 4 * (n & 1) + (fr & 3)) * 1280 + 8 * fq;
        f32x4 acc[4];
#pragma unroll
        for (int n = 0; n < 4; ++n) acc[n] = (f32x4){0.f, 0.f, 0.f, 0.f};
#pragma unroll 8
        for (int st = s0; st < s1; ++st) { const bf16x8 a = *(const bf16x8*)(ap + 32 * st);
#pragma unroll
            for (int n = 0; n < 4; ++n) acc[n] = __builtin_amdgcn_mfma_f32_16x16x32_bf16(*(const bf16x8*)(bp[n] + 32 * st), a, acc[n], 0, 0, 0); }
#pragma unroll
        for (int n = 0; n < 4; ++n) part[(wid * 4 + n) * 64 + lane] = acc[n];
        __syncthreads();
        if (wid == 0) { const int row = row0 + fr; const float rs = row_rstd(ssq, row, fq); float sq = 0.f;
#pragma unroll
            for (int gq = 0; gq < 2; ++gq) { const int col = col0 + 32 * gq + 8 * fq;
                f32x4 g0 = part[(2 * gq) * 64 + lane], g1 = part[(2 * gq + 1) * 64 + lane];
#pragma unroll
                for (int w = 1; w < 7; ++w) { g0 += part[(w * 4 + 2 * gq) * 64 + lane]; g1 += part[(w * 4 + 2 * gq + 1) * 64 + lane]; }
                const f32x4 p0 = part[(7 * 4 + 2 * gq) * 64 + lane], p1 = part[(7 * 4 + 2 * gq + 1) * 64 + lane];
                f32x4 x0, x1; unpack8(*(const u32x4*)(A + (size_t)row * XLD + col), x0, x1);
#pragma unroll
                for (int i = 0; i < 4; ++i) { x0[i] += sigmoidf_(g0[i] * rs) * p0[i]; x1[i] += sigmoidf_(g1[i] * rs) * p1[i]; }
                *(u32x4*)(xout + (size_t)row * XLD + col) = pack8(x0, x1); sq += sumsq8(x0, x1); }
            sq += __shfl_xor(sq, 16); sq += __shfl_xor(sq, 32);
            if (fq == 0) ssq_out[(size_t)row * 16 + cg] = sq;
        }
        __syncthreads();
    }
}

struct AttnD { long rowbase; int dstride, qt0, qcol, kcol, vcol, ldo; bf16_t* obase; float* lsep; bool has_sink; float sink2; };
constexpr int ATT_V_OFF = 12 * 4608;
__device__ __forceinline__ AttnD attn_decode(int u, int hh, bf16_t* obr, bf16_t* odil, float* lse, const float* sinks) {
    AttnD d;
    if (u < 256) { const int blk = u & 15, kvh = (u >> 4) & 1, b = u >> 5, h = 4 * kvh + hh;
        d.rowbase = (long)b * SEQ; d.dstride = 1; d.qt0 = 8 * blk; d.qcol = ZC_QS + 64 * h; d.kcol = ZC_KS + 64 * kvh; d.vcol = ZC_VS + 64 * kvh;
        d.obase = obr + 512 + 64 * h; d.ldo = OBR_LD; d.lsep = nullptr; d.has_sink = true; d.sink2 = sinks[h] * LOG2E;
    } else { const int v = u - 256, gi = v >> 9, w = v & 511, blk16 = w & 15, h = (w >> 4) & 3, b = w >> 6, sh = 2 * gi, bps = 16 >> sh, r = blk16 / bps, blk = blk16 % bps, cb = ZC_DIL + 768 * gi;
        d.rowbase = (long)b * SEQ + r; d.dstride = 1 << sh; d.qt0 = 8 * blk; d.qcol = cb + 64 * h; d.kcol = cb + 256 + 64 * h; d.vcol = cb + 512 + 64 * h;
        d.obase = odil + (size_t)gi * MTP * 256 + 64 * h; d.ldo = 256; d.lsep = lse + (size_t)gi * MTP * 4 + h; d.has_sink = false; d.sink2 = 0.f; }
    return d;
}
__device__ __forceinline__ void attn_issue(const AttnD& d, const bf16_t* z, u32x4 (&pf)[12], bf16x8 (&qf)[4], int tid, int wave, int lane, int mode) {
    const int within = tid & 255, row = within >> 3, cc = within & 7, t0 = tid >> 8;
    if (mode == 2)
#pragma unroll
    for (int i = 0; i < 12; ++i) { const int tile = 2 * (i % 6) + t0; int kt = d.qt0 - 4 + tile; kt = kt < 0 ? 0 : kt;
        pf[i] = *(const u32x4*)(z + (size_t)(d.rowbase + (long)(32 * kt + row) * d.dstride) * DIN + (i < 6 ? d.kcol : d.vcol) + 8 * cc); }
    const int r32 = lane & 31, hi = lane >> 5;
    const bf16_t* zq = z + (size_t)(d.rowbase + (long)(32 * (d.qt0 + wave) + r32) * d.dstride) * DIN + d.qcol + 8 * hi;
#pragma unroll
    for (int s = 0; s < 4; ++s) qf[s] = *(const bf16x8*)(zq + 16 * s);
}
__device__ __forceinline__ void attn_stage(LAS unsigned char* lds, const u32x4 (&pf)[12], int tid) {
    const int within = tid & 255, row = within >> 3, cc = within & 7, t0 = tid >> 8;
#pragma unroll
    for (int i = 0; i < 12; ++i) { const int tile = 2 * (i % 6) + t0; *(LAS u32x4*)(lds + (i < 6 ? 0 : ATT_V_OFF) + tile * 4608 + row * 144 + cc * 16) = pf[i]; }
}
__device__ __forceinline__ void attn_wg_compute(const AttnD& d, const bf16x8 (&qf)[4], LAS unsigned char* lds, int wave, int lane, int mode, const AttnD& dn, const bf16_t* z, u32x4 (&pf)[12], bf16x8 (&qn)[4], int tid) {
    const int r32 = lane & 31, hi = lane >> 5, qt = d.qt0 + wave;
    const float NEG = -__builtin_inff();
    if (mode) attn_issue(dn, z, pf, qn, tid, wave, lane, mode);
    __builtin_amdgcn_sched_barrier(0);
    f32x16 S[5];
    const LAS unsigned char* kb = lds + wave * 4608 + r32 * 144 + 16 * hi;
#pragma unroll
    for (int j = 0; j < 5; ++j) { f32x16 acc;
#pragma unroll
        for (int r = 0; r < 16; ++r) acc[r] = 0.f;
#pragma unroll
        for (int s = 0; s < 4; ++s) acc = __builtin_amdgcn_mfma_f32_32x32x16_bf16(*(const LAS bf16x8*)(kb + j * 4608 + 32 * s), qf[s], acc, 0, 0, 0);
        S[j] = acc; }
    float m = NEG;
#pragma unroll
    for (int j = 0; j < 5; ++j) { const bool tv = (qt - 4 + j) >= 0;
#pragma unroll
        for (int r = 0; r < 16; ++r) { const int kk = (r & 3) + 8 * (r >> 2) + 4 * hi; float v = S[j][r];
            if (j == 0) v = (kk < r32) ? NEG : v;
            if (j == 4) v = (kk > r32) ? NEG : v;
            if (j < 4) v = tv ? v : NEG;
            S[j][r] = v; m = fmaxf(m, v); } }
    m = fmaxf(m, __shfl_xor(m, 32));
    float m2 = m * SCL2;
    if (d.has_sink) m2 = fmaxf(m2, d.sink2);
    u32x4 PW[5][2]; float l = 0.f;
#pragma unroll
    for (int j = 0; j < 5; ++j)
#pragma unroll
        for (int s2 = 0; s2 < 2; ++s2) { float p[8];
#pragma unroll
            for (int i = 0; i < 8; ++i) { p[i] = __builtin_amdgcn_exp2f(__builtin_fmaf(S[j][8 * s2 + i], SCL2, -m2)); l += p[i]; }
            PW[j][s2].x = pk2(p[0], p[1]); PW[j][s2].y = pk2(p[2], p[3]); PW[j][s2].z = pk2(p[4], p[5]); PW[j][s2].w = pk2(p[6], p[7]); }
    l += __shfl_xor(l, 32);
    if (d.has_sink) l += __builtin_amdgcn_exp2f(d.sink2 - m2);
    const float inv = __builtin_amdgcn_rcpf(l);
    LAS float* iscr = (LAS float*)(lds + 2 * ATT_V_OFF) + wave * 32;
    if (hi == 0) iscr[r32] = inv;
    f32x16 O0, O1;
#pragma unroll
    for (int r = 0; r < 16; ++r) { O0[r] = 0.f; O1[r] = 0.f; }
    const int q4 = (lane & 15) >> 2, p4 = lane & 3, blk = (lane >> 4) & 1;
    const LAS unsigned char* trb = lds + ATT_V_OFF + wave * 4608 + (4 * hi + q4) * 144 + (16 * blk + 4 * p4) * 2;
#pragma unroll
    for (int j = 0; j < 5; ++j) {
#pragma unroll
        for (int s2 = 0; s2 < 2; ++s2) {
            const bf16x8 pa = __builtin_bit_cast(bf16x8, PW[j][s2]);
#pragma unroll
            for (int dh = 0; dh < 2; ++dh) {
                const s16x4 lo = __builtin_bit_cast(s16x4, __builtin_amdgcn_ds_read_tr16_b64_v4i16((LAS s16x4*)(trb + j * 4608 + (16 * s2) * 144 + 64 * dh)));
                const s16x4 hh = __builtin_bit_cast(s16x4, __builtin_amdgcn_ds_read_tr16_b64_v4i16((LAS s16x4*)(trb + j * 4608 + (16 * s2 + 8) * 144 + 64 * dh)));
                const bf16x8 vb = __builtin_shufflevector(lo, hh, 0, 1, 2, 3, 4, 5, 6, 7);
                if (dh == 0) O0 = __builtin_amdgcn_mfma_f32_32x32x16_bf16(pa, vb, O0, 0, 0, 0);
                else         O1 = __builtin_amdgcn_mfma_f32_32x32x16_bf16(pa, vb, O1, 0, 0, 0);
            }
        }
    }
    bf16_t* ob = d.obase + (size_t)(d.rowbase + (long)(32 * qt + 4 * hi) * d.dstride) * d.ldo + r32;
#pragma unroll
    for (int g4 = 0; g4 < 4; ++g4) { const f32x4 iv = *(const LAS f32x4*)(iscr + 8 * g4 + 4 * hi);
#pragma unroll
        for (int i = 0; i < 4; ++i) { const int r = 4 * g4 + i, q = 8 * g4 + i; bf16_t* p = ob + (size_t)((long)q * d.dstride) * d.ldo; p[0] = f2bf(O0[r] * iv[i]); p[32] = f2bf(O1[r] * iv[i]); } }
    if (d.lsep && hi == 0) d.lsep[(size_t)(d.rowbase + (long)(32 * qt + r32) * d.dstride) * 4] = (m2 + __builtin_amdgcn_logf(l)) * LN2;
}

__device__ __forceinline__ void attn_phase_wg(const bf16_t* z, bf16_t* obr, bf16_t* odil, float* lse, const float* sinks, LAS unsigned char* lds, int bx, int G) {
    int tid_ = threadIdx.x; asm volatile("" : "+v"(tid_));
    const int tid = tid_, lane = tid & 63, wave = __builtin_amdgcn_readfirstlane(tid >> 6);
    u32x4 pf[12]; bf16x8 qf[4], qn[4];
    constexpr int NU = 256 + 1536;
    int u = (G % 8 == 0) ? (bx % 8) * 32 + (bx / 8) % 32 + (bx / 256) * 256 : bx;
    if (u < NU) { const AttnD d0 = attn_decode(u, 0, obr, odil, lse, sinks); attn_issue(d0, z, pf, qn, tid, wave, lane, 2); }
    for (; u < NU; u += G) {
        asm volatile("s_waitcnt lgkmcnt(0)\n\ts_barrier" ::: "memory");
        attn_stage(lds, pf, tid);
        asm volatile("s_waitcnt lgkmcnt(0)\n\ts_barrier" ::: "memory");
        const int nh = (u < 256) ? 4 : 1; const bool has_next = u + G < NU;
        for (int hh = 0; hh < nh; ++hh) {
            const AttnD d = attn_decode(u, hh, obr, odil, lse, sinks);
#pragma unroll
            for (int s = 0; s < 4; ++s) qf[s] = qn[s];
            const bool lasth = hh + 1 == nh; const int mode = lasth ? (has_next ? 2 : 0) : 1;
            const AttnD dn = lasth ? attn_decode(has_next ? u + G : u, 0, obr, odil, lse, sinks) : attn_decode(u, hh + 1, obr, odil, lse, sinks);
            attn_wg_compute(d, qf, lds, wave, lane, mode, dn, z, pf, qn, tid);
        }
    }
    __syncthreads();
}

__device__ __forceinline__ void sample_attn_core(const bf16_t* zrow  , int qcol, int kcol, int vcol, const float* cache  , int rowf  ,
                                                 int vofs  , int dil, bool has_sink, float sink2, LAS unsigned char* wl, int lane, f32x4& o_out, float& lse_out) {
    const int sub = lane & 15, kg = lane >> 4;
    const float NEG = -__builtin_inff();
    f32x4 q; { const u32x2 w = *(const u32x2*)(zrow + qcol + 4 * sub); q = (f32x4){bflo(w.x), bfhi(w.x), bflo(w.y), bfhi(w.y)}; }
    f32x4 kn; { const u32x2 w = *(const u32x2*)(zrow + kcol + 4 * sub); kn = (f32x4){bflo(w.x), bfhi(w.x), bflo(w.y), bfhi(w.y)}; }
    f32x4 vn; { const u32x2 w = *(const u32x2*)(zrow + vcol + 4 * sub); vn = (f32x4){bflo(w.x), bfhi(w.x), bflo(w.y), bfhi(w.y)}; }
    LAS float* scl = (LAS float*)wl;
    float m = NEG;
#pragma unroll 16
    for (int st = 0; st < 32; ++st) { const int key = 4 * st + kg;
        const f32x4 k4 = *(const f32x4*)(cache + (size_t)key * dil * rowf + 4 * sub);
        float d = (q[0] * k4[0] + q[1] * k4[1]) + (q[2] * k4[2] + q[3] * k4[3]);
        d += __shfl_xor(d, 1); d += __shfl_xor(d, 2); d += __shfl_xor(d, 4); d += __shfl_xor(d, 8);
        d *= SCL2; m = fmaxf(m, d);
        if (sub == 0) scl[st * 4 + kg] = d; }
    float sn = (q[0] * kn[0] + q[1] * kn[1]) + (q[2] * kn[2] + q[3] * kn[3]);
    sn += __shfl_xor(sn, 1); sn += __shfl_xor(sn, 2); sn += __shfl_xor(sn, 4); sn += __shfl_xor(sn, 8);
    sn *= SCL2;
    m = fmaxf(m, sn);
    m = fmaxf(m, __shfl_xor(m, 16)); m = fmaxf(m, __shfl_xor(m, 32));
    if (has_sink) m = fmaxf(m, sink2);
    float l = 0.f; f32x4 o = {0.f, 0.f, 0.f, 0.f};
#pragma unroll 16
    for (int st = 0; st < 32; ++st) { const int key = 4 * st + kg; const float p = __builtin_amdgcn_exp2f(scl[st * 4 + kg] - m); l += p;
        const f32x4 v4 = *(const f32x4*)(cache + (size_t)key * dil * rowf + vofs + 4 * sub); o += v4 * p; }
    l += __shfl_xor(l, 16); l += __shfl_xor(l, 32);
#pragma unroll
    for (int i = 0; i < 4; ++i) { o[i] += __shfl_xor(o[i], 16); o[i] += __shfl_xor(o[i], 32); }
    const float pn = __builtin_amdgcn_exp2f(sn - m); l += pn; o += vn * pn;
    if (has_sink) l += __builtin_amdgcn_exp2f(sink2 - m);
    const float inv = 1.f / l;
    o_out = o * inv; lse_out = (m + __builtin_amdgcn_logf(l)) * LN2;
}

__device__ __forceinline__ void sample_dil_unit(const bf16_t* zrow, int cb, const float* cache  , int dil, bf16_t* orow  , float* lserow  , LAS unsigned char* wl, int lane) {
    const int sub = lane & 15, head = lane >> 4, co = 64 * head + 4 * sub;
    f32x4 q; { const u32x2 w = *(const u32x2*)(zrow + cb + co); q = (f32x4){bflo(w.x), bfhi(w.x), bflo(w.y), bfhi(w.y)}; }
    f32x4 kn; { const u32x2 w = *(const u32x2*)(zrow + cb + 256 + co); kn = (f32x4){bflo(w.x), bfhi(w.x), bflo(w.y), bfhi(w.y)}; }
    f32x4 vn; { const u32x2 w = *(const u32x2*)(zrow + cb + 512 + co); vn = (f32x4){bflo(w.x), bfhi(w.x), bflo(w.y), bfhi(w.y)}; }
    LAS float* scl = (LAS float*)wl;
    const float* kp = cache + co; const size_t rs = (size_t)dil * 512;
    float m = -__builtin_inff();
#pragma unroll 1
    for (int s0 = 0; s0 < 128; s0 += 32) { f32x4 kb[32];
#pragma unroll
        for (int i = 0; i < 32; ++i) kb[i] = __builtin_nontemporal_load((const f32x4*)(kp + (size_t)(s0 + i) * rs));
#pragma unroll
        for (int i = 0; i < 32; ++i) { float d = (q[0] * kb[i][0] + q[1] * kb[i][1]) + (q[2] * kb[i][2] + q[3] * kb[i][3]);
            d += __shfl_xor(d, 1); d += __shfl_xor(d, 2); d += __shfl_xor(d, 4); d += __shfl_xor(d, 8);
            d *= SCL2; m = fmaxf(m, d); if (sub == 0) scl[(s0 + i) * 4 + head] = d; } }
    float sn = (q[0] * kn[0] + q[1] * kn[1]) + (q[2] * kn[2] + q[3] * kn[3]);
    sn += __shfl_xor(sn, 1); sn += __shfl_xor(sn, 2); sn += __shfl_xor(sn, 4); sn += __shfl_xor(sn, 8);
    sn *= SCL2; m = fmaxf(m, sn);
    float l = 0.f; f32x4 o = {0.f, 0.f, 0.f, 0.f};
#pragma unroll 1
    for (int s0 = 0; s0 < 128; s0 += 32) { f32x4 vb[32];
#pragma unroll
        for (int i = 0; i < 32; ++i) vb[i] = __builtin_nontemporal_load((const f32x4*)(kp + 256 + (size_t)(s0 + i) * rs));
#pragma unroll
        for (int i = 0; i < 32; ++i) { const float p = __builtin_amdgcn_exp2f(scl[(s0 + i) * 4 + head] - m); l += p; o += vb[i] * p; } }
    const float pn = __builtin_amdgcn_exp2f(sn - m); l += pn; o += vn * pn;
    const float inv = __builtin_amdgcn_rcpf(l);
    { u32x2 w; w.x = pk2(o[0] * inv, o[1] * inv); w.y = pk2(o[2] * inv, o[3] * inv); *(u32x2*)(orow + co) = w; }
    if (sub == 0) lserow[head] = (m + __builtin_amdgcn_logf(l)) * LN2;
}

#define XB_TMO      128
#define XB_XCNT(j)  (256  + 64 * (j))
#define XB_XSUB(j)  (1280 + 64 * (j))
#define XB_XGEN(j)  (2304 + 64 * (j))
#define XB_TOP      3328
#define XB_TOPGEN   3392
#define XCD_BAR_WORDS 3456
#define XB_SPIN_CAP (1u << 18)
__device__ __forceinline__ unsigned xb_ld(unsigned* p)              { return __hip_atomic_load(p, __ATOMIC_RELAXED, __HIP_MEMORY_SCOPE_AGENT); }
__device__ __forceinline__ unsigned xb_add(unsigned* p, unsigned v) { return __hip_atomic_fetch_add(p, v, __ATOMIC_RELAXED, __HIP_MEMORY_SCOPE_AGENT); }
__device__ __forceinline__ unsigned xb_xcc_id() { return (unsigned)__builtin_amdgcn_s_getreg((3 << 11) | 20) & 0xFu; }
#define XB_SPIN(cond, bar) do { unsigned _sp = 0; while (cond) { __builtin_amdgcn_s_sleep(1); \
    if ((++_sp & 255u) == 0u) { if (xb_ld(&(bar)[XB_TMO])) break; if (_sp > XB_SPIN_CAP) { atomicAdd(&(bar)[XB_TMO], 1u); break; } } } } while (0)
struct XcdBarrier { unsigned* bar; unsigned x; volatile LAS unsigned* st; };
__device__ __forceinline__ XcdBarrier xcd_barrier_post(unsigned* bar, volatile LAS unsigned* st) {
    XcdBarrier b; b.bar = bar; b.x = xb_xcc_id(); b.st = st;
    if (threadIdx.x == 0) (void)xb_add(&bar[XB_XCNT(b.x)], 1u);
    return b;
}
__device__ __forceinline__ void xcd_barrier_complete(unsigned* bar, unsigned x, unsigned& nloc, unsigned& nx) {
    const unsigned G = gridDim.x * gridDim.y * gridDim.z;
    unsigned sum, cnt, mine, sp = 0u;
    for (;;) {
        sum = 0u; cnt = 0u; mine = 0u;
#pragma unroll
        for (unsigned j = 0; j < 16; ++j) { const unsigned c = xb_ld(&bar[XB_XCNT(j)]); sum += c; cnt += (c > 0u) ? 1u : 0u; mine = (j == x) ? c : mine; }
        if (sum == G) break;
        __builtin_amdgcn_s_sleep(1);
        if ((++sp & 255u) == 0u) { if (xb_ld(&bar[XB_TMO])) break; if (sp > XB_SPIN_CAP) { atomicAdd(&bar[XB_TMO], 1u); break; } }
    }
    nloc = mine > 0u ? mine : 1u; nx = cnt > 0u ? cnt : 1u;
}
__device__ __forceinline__ void xcd_barrier(const XcdBarrier& b) {
    asm volatile("s_waitcnt vmcnt(0)" ::: "memory");
    __syncthreads();
    if (threadIdx.x == 0) {
        unsigned* bar = b.bar;
        __builtin_amdgcn_s_waitcnt(0);
        unsigned nloc = b.st[0], nx = b.st[1];
        if (nloc == 0u) { xcd_barrier_complete(bar, b.x, nloc, nx); b.st[0] = nloc; b.st[1] = nx; }
        const unsigned old = xb_add(&bar[XB_XSUB(b.x)], 1u);
        const unsigned gen = old / nloc;
        if (old + 1u == (gen + 1u) * nloc) {
            __builtin_amdgcn_fence(__ATOMIC_RELEASE, "agent");
            asm volatile("s_waitcnt vmcnt(0)" ::: "memory");
            const unsigned og = xb_add(&bar[XB_TOP], 1u);
            const unsigned tg = og / nx;
            if (og + 1u == (tg + 1u) * nx) xb_add(&bar[XB_TOPGEN], 1u);
            else XB_SPIN(xb_ld(&bar[XB_TOPGEN]) == tg, bar);
            __builtin_amdgcn_fence(__ATOMIC_ACQUIRE, "agent");
            xb_add(&bar[XB_XGEN(b.x)], 1u);
            asm volatile("s_waitcnt vmcnt(0)" ::: "memory");
        } else {
            XB_SPIN(xb_ld(&bar[XB_XGEN(b.x)]) == gen, bar);
            __builtin_amdgcn_fence(__ATOMIC_ACQUIRE, "agent");
            asm volatile("s_waitcnt vmcnt(0)" ::: "memory");
        }
    }
    __syncthreads();
}

constexpr int RING_BYTES = 131072, LDS_BYTES = 163840, MISC_OFF = LDS_BYTES - 512;
constexpr int C_ES = 0, C_ES_LD = 272, C_T = 256 * C_ES_LD  , C_WS = C_T + 77824  , C_WS_SZ = 2048;
static_assert(C_WS + 7 * C_WS_SZ <= MISC_OFF, "phase C LDS map");
constexpr int NWAVES = 8, NTHREADS = 512;

__device__ __forceinline__ void p0_transpose_item(const float* W, int K, int N, bf16_t* WT, int ldw, const float* gain, LAS unsigned char* scr, int item, int lane) {
    const int nblk = N / 64, kb = item / nblk, nb = item % nblk, k0 = 64 * kb, n0 = 64 * nb;
    const float* src = W + (size_t)k0 * N + n0 + lane;
    float v[64];
#pragma unroll
    for (int k = 0; k < 64; ++k) v[k] = __builtin_nontemporal_load(src + (size_t)k * N);
    if (gain) {
#pragma unroll
        for (int k = 0; k < 64; ++k) v[k] *= gain[k0 + k];
    }
#pragma unroll
    for (int c = 0; c < 8; ++c) { u32x4 o; o.x = pk2(v[8 * c], v[8 * c + 1]); o.y = pk2(v[8 * c + 2], v[8 * c + 3]); o.z = pk2(v[8 * c + 4], v[8 * c + 5]); o.w = pk2(v[8 * c + 6], v[8 * c + 7]);
        *(LAS u32x4*)(scr + lane * 144 + c * 16) = o; }
    LDS_WAIT(); asm volatile("" ::: "memory");
    bf16_t* dst = WT + (size_t)n0 * ldw + k0 + 8 * (lane & 7);
#pragma unroll
    for (int j = 0; j < 8; ++j) { const int r = 8 * j + (lane >> 3); const u32x4 o = *(const LAS u32x4*)(scr + r * 144 + (lane & 7) * 16); *(u32x4*)(dst + (size_t)r * ldw) = o; }
    LDS_WAIT(); asm volatile("" ::: "memory");
}

struct Args { const float* in[33]; float* out; unsigned char* ws; int ph_lo, ph_hi; };
constexpr int NPHASE = 22;

__global__ void __launch_bounds__(NTHREADS, 2) fwd_kernel(Args args) {
    extern __shared__ __attribute__((aligned(16))) unsigned char lds_raw[];
    LAS unsigned char* lds = (LAS unsigned char*)lds_raw;
    const int tid = threadIdx.x, lane = tid & 63, wave = __builtin_amdgcn_readfirstlane(tid >> 6);
    const int G = gridDim.x; const int bx = blockIdx.x; const int vcu = (G % 8 == 0) ? (bx % 8) * (G / 8) + bx / 8 : bx;
    const int gw = vcu * NWAVES + wave, NGW = G * NWAVES;
    const int gth = vcu * NTHREADS + tid, NGT = G * NTHREADS;
    unsigned char* ws = args.ws;
    unsigned* ctl = (unsigned*)(ws + WS_CTL);
    volatile LAS unsigned* MISC = (volatile LAS unsigned*)(lds + MISC_OFF);
    for (int u = tid; u < (LDS_BYTES - RING_BYTES) / 4; u += NTHREADS) ((LAS unsigned*)(lds + RING_BYTES))[u] = 0u;
    __syncthreads();
#if MK_ONE_LAUNCH
    XcdBarrier bar = xcd_barrier_post(ctl + 1024, MISC + 8);
#define GRID_BAR() xcd_barrier(bar)
#else
#define GRID_BAR() do { } while (0)
#endif
    const int lo = args.ph_lo, hi = args.ph_hi;
#ifndef PHM
#define PHM 0xFFFFFFFFu
#endif
#define IN(k) (lo <= (k) && (k) < hi)
#define INL(j) (((PHM >> (1 + (j))) & 1u) && IN(pbase + (j)))
#ifndef REPM
#define REPM 0u
#endif
#define NREP(k) (((REPM >> (k)) & 1u) ? 2 : 1)
#ifndef REPB
#define REPB 0u
#endif
#define NREPB(b) ((REPB & (b)) ? 2 : 1)
#ifndef REPP
#define REPP 0u
#endif
#define NREPP(b) ((REPP & (b)) ? 2 : 1)
#ifndef REPC
#define REPC 0u
#endif
#define NREPC(b) ((REPC & (b)) ? 2 : 1)
#define SEAM(k) do { if (IN(k) && IN((k) + 1)) GRID_BAR(); } while (0)

    bf16_t* xbdum = (bf16_t*)(ws + WS_XBDUM); float* ssqdum = (float*)(ws + WS_SSQDUM); (void)xbdum; (void)ssqdum;
    bf16_t* z = (bf16_t*)(ws + WS_Z);
    bf16_t* obr = (bf16_t*)(ws + WS_OBR);
    bf16_t* odil = (bf16_t*)(ws + WS_ODIL);
    float* lse = (float*)(ws + WS_LSE);
    float* Ebuf = (float*)(ws + WS_E);
    bf16_t* Sin = (bf16_t*)(ws + WS_SIN);
    bf16_t* gact = (bf16_t*)(ws + WS_GACT);
    bf16_t* merged = (bf16_t*)(ws + WS_MERGED);
    bf16_t* hid = (bf16_t*)(ws + WS_HID);
    bf16_t* ppb = (bf16_t*)(ws + WS_PP);

    if ((PHM & 1u) && IN(0)) for (int rep = 0; rep < NREP(0); ++rep) {
        const int GA = (G > 128) ? G - 64 : G;
        LAS unsigned char* scr = lds + wave * 16384;
        constexpr int I_IN = (D / 64) * (DIN / 64), I_GLU = 8 * 8, I_BA = 8 * 16, I_BC = 4 * 16, I_OUT = 16 * 16, I_UP = 16 * 64, I_DOWN = 64 * 16, I_PP = 4 * 16;
        constexpr int I_L = I_IN + I_GLU + 2 * I_BA + I_BC + I_OUT + I_UP + I_DOWN + I_OUT + I_PP;
        for (int rp = 0; rp < NREPP(1u); ++rp)
        if (bx < GA)
        for (int it = bx * NWAVES + wave; it < NLAYER * I_L; it += GA * NWAVES) {
            const int l = it / I_L; int r = it % I_L;
            bf16_t* wl_ = (bf16_t*)(ws + WS_W + (size_t)l * WL_BYTES);
            if (r < I_IN) { p0_transpose_item(args.in[9] + (size_t)l * D * DIN, D, DIN, wl_ + WO_IN, D, args.in[10] + l * D, scr, r, lane); continue; } r -= I_IN;
            if (r < I_GLU) { p0_transpose_item(args.in[19] + (size_t)l * 512 * 512, 512, 512, wl_ + WO_GLU, 512, nullptr, scr, r, lane); continue; } r -= I_GLU;
            if (r < I_BA) { p0_transpose_item(args.in[22] + (size_t)l * 512 * D, 512, D, wl_ + WO_BR, 1280, nullptr, scr, r, lane); continue; } r -= I_BA;
            if (r < I_BA) { p0_transpose_item(args.in[23] + (size_t)l * 512 * D, 512, D, wl_ + WO_BR + 512, 1280, nullptr, scr, r, lane); continue; } r -= I_BA;
            if (r < I_BC) { p0_transpose_item(args.in[24] + (size_t)l * 256 * D, 256, D, wl_ + WO_BR + 1024, 1280, nullptr, scr, r, lane); continue; } r -= I_BC;
            if (r < I_OUT) { p0_transpose_item(args.in[25] + (size_t)l * D * D, D, D, wl_ + WO_OUT, D, nullptr, scr, r, lane); continue; } r -= I_OUT;
            if (r < I_UP) { p0_transpose_item(args.in[27] + (size_t)l * D * DFF, D, DFF, wl_ + WO_UP, D, args.in[26] + l * D, scr, r, lane); continue; } r -= I_UP;
            if (r < I_DOWN) { p0_transpose_item(args.in[28] + (size_t)l * DFF * D, DFF, D, wl_ + WO_DOWN, DFF, nullptr, scr, r, lane); continue; } r -= I_DOWN;
            if (r < I_OUT) { p0_transpose_item(args.in[30] + (size_t)l * D * D, D, D, wl_ + WO_PGP, 1280, args.in[29] + l * D, scr, r, lane); continue; } r -= I_OUT;
            p0_transpose_item(args.in[31] + (size_t)l * PLE * D, PLE, D, wl_ + WO_PGP + 1024, 1280, nullptr, scr, r, lane);
        }
        { bf16_t* xb0 = (bf16_t*)(ws + WS_XB0); float* ssq0 = (float*)(ws + WS_SSQ0);
          for (int rp = 0; rp < NREPP(2u); ++rp)
          for (int m0 = 4 * gw; m0 < MT; m0 += 4 * NGW) {
            f32x4 v[4][4];
#pragma unroll
            for (int rr = 0; rr < 4; ++rr) { const int m = m0 + rr; const float* src = (m < MP) ? args.in[0] + (size_t)m * D : args.in[1] + (size_t)(m - MP) * D;
#pragma unroll
                for (int j = 0; j < 4; ++j) v[rr][j] = __builtin_nontemporal_load((const f32x4*)(src + 4 * lane + 256 * j)); }
#pragma unroll
            for (int rr = 0; rr < 4; ++rr) { const int m = m0 + rr; float sq = 0.f;
#pragma unroll
                for (int j = 0; j < 4; ++j) { sq += (v[rr][j][0] * v[rr][j][0] + v[rr][j][1] * v[rr][j][1]) + (v[rr][j][2] * v[rr][j][2] + v[rr][j][3] * v[rr][j][3]);
                    u32x2 w; w.x = pk2(v[rr][j][0], v[rr][j][1]); w.y = pk2(v[rr][j][2], v[rr][j][3]); *(u32x2*)(xb0 + (size_t)m * XLD + 4 * lane + 256 * j) = w; }
                sq = wave_sum(sq);
                if (lane < 16) ssq0[(size_t)m * 16 + lane] = (lane == 0) ? sq : 0.f; }
          } }
        for (int rp = 0; rp < NREPP(4u); ++rp)
#pragma unroll 4
        for (int it = gth; it < NLAYER * MT * 32; it += NGT) {
            const int l = it / (MT * 32), r = it % (MT * 32), m = r >> 5, c8 = r & 31;
            const float* src = (m < MP) ? args.in[7] + ((size_t)l * MP + m) * PLE + 8 * c8 : args.in[8] + ((size_t)l * MS + (m - MP)) * PLE + 8 * c8;
            const f32x4 a = __builtin_nontemporal_load((const f32x4*)src), b = __builtin_nontemporal_load((const f32x4*)(src + 4));
            *(u32x4*)((bf16_t*)(ws + (l ? WS_XB1 : WS_XB0)) + (size_t)m * XLD + 1024 + 8 * c8) = pack8(a, b);
        }
        for (int rp = 0; rp < NREPP(8u); ++rp)
        for (int it = (G > 128) ? bx - (G - 64) : bx; it >= 0 && it < NLAYER * 32; it += (G > 128) ? 64 : G) {
            const int l = it >> 5, g = it & 31;
            LAS float* lamp = (LAS float*)lds;
            LAS float* bbs = lamp + 17 * 64 * 2;
            LAS float* cs = bbs + 64 * 16 * 2;
            unsigned char* sl = ws + WS_SSM + (size_t)l * SL_BYTES;
            __syncthreads();
            { const int p = tid & 63, kg = tid >> 6;
                const double dt = exp((double)args.in[13][l * 32 + g]);
                const double are = args.in[11][(l * 32 + g) * 64 + p], aim = args.in[12][(l * 32 + g) * 64 + p];
                for (int k = kg; k <= 16; k += 8) { const double mag = exp(k * are * dt), ang = k * aim * dt; const float cr = (float)(mag * cos(ang)), ci = (float)(mag * sin(ang));
                    lamp[(k * 64 + p) * 2] = cr; lamp[(k * 64 + p) * 2 + 1] = ci;
                    if (k == 16) { float* LAM16 = (float*)(sl + SO_LAM16) + (g * 64 + p) * 2; LAM16[0] = cr; LAM16[1] = ci; } }
                if (kg == 1) {
                    const double mag = exp(are * dt), lr = mag * cos(aim * dt), li = mag * sin(aim * dt), den = are * are + aim * aim;
                    const double zr = ((lr - 1.0) * are + li * aim) / den, zi = (li * are - (lr - 1.0) * aim) / den;
                    float* LAM = (float*)(sl + SO_LAM) + (g * 64 + p) * 2; float* BBo = (float*)(sl + SO_BB) + (size_t)(g * 64 + p) * 32;
                    LAM[0] = (float)lr; LAM[1] = (float)li;
                    for (int h = 0; h < 16; ++h) { const double br = args.in[14][((size_t)(l * 32 + g) * 64 + p) * 16 + h], bi = args.in[15][((size_t)(l * 32 + g) * 64 + p) * 16 + h];
                        const float xr = (float)(zr * br - zi * bi), xi = (float)(zr * bi + zi * br);
                        bbs[(p * 16 + h) * 2] = xr; bbs[(p * 16 + h) * 2 + 1] = xi; BBo[h * 2] = xr; BBo[h * 2 + 1] = xi; }
                }
            }
            for (int e = tid; e < 1024; e += NTHREADS) { cs[e * 2] = args.in[16][(size_t)(l * 32 + g) * 1024 + e]; cs[e * 2 + 1] = args.in[17][(size_t)(l * 32 + g) * 1024 + e]; }
            __syncthreads();
            bf16_t* KT = (bf16_t*)(sl + SO_KT) + (size_t)g * 4096; bf16_t* GT = (bf16_t*)(sl + SO_GT) + (size_t)g * 32768; bf16_t* Ft = (bf16_t*)(sl + SO_F) + (size_t)g * 32768;
            for (int e = tid; e < 4096; e += NTHREADS) { const int lag = e >> 8, hp = (e >> 4) & 15, h = e & 15; float s = 0.f;
                for (int p = 0; p < 64; ++p) { const float lr = lamp[(lag * 64 + p) * 2], li = lamp[(lag * 64 + p) * 2 + 1], br = bbs[(p * 16 + h) * 2], bi = bbs[(p * 16 + h) * 2 + 1];
                    const float wr_ = lr * br - li * bi, wi_ = lr * bi + li * br; s += cs[(hp * 64 + p) * 2] * wr_ - cs[(hp * 64 + p) * 2 + 1] * wi_; }
                if (lag == 0 && hp == h) s += args.in[18][l * 512 + g * 16 + h];
                KT[e] = f2bf(s); }
            for (int e = tid; e < 32768; e += NTHREADS) { const int t = e >> 11, hp = (e >> 7) & 15, ri = e & 1, p = (e >> 1) & 63;
                const float lr = lamp[((t + 1) * 64 + p) * 2], li = lamp[((t + 1) * 64 + p) * 2 + 1], cr = cs[(hp * 64 + p) * 2], ci = cs[(hp * 64 + p) * 2 + 1];
                GT[e] = f2bf(ri == 0 ? (cr * lr - ci * li) : -(cr * li + ci * lr)); }
            for (int e = tid; e < 32768; e += NTHREADS) { const int ri = (e >> 8) & 1, p = e >> 9, j = (e >> 4) & 15, h = e & 15;
                const float lr = lamp[((15 - j) * 64 + p) * 2], li = lamp[((15 - j) * 64 + p) * 2 + 1], br = bbs[(p * 16 + h) * 2], bi = bbs[(p * 16 + h) * 2 + 1];
                Ft[e] = f2bf(ri == 0 ? (lr * br - li * bi) : (lr * bi + li * br)); }
        }
        __syncthreads();
    }
    SEAM(0);

    for (int l = 0; l < NLAYER; ++l) {
        const int pbase = 1 + 10 * l;
        bf16_t* wl_ = (bf16_t*)(ws + WS_W + (size_t)l * WL_BYTES);
        unsigned char* sl = ws + WS_SSM + (size_t)l * SL_BYTES;
        bf16_t* xb_cur = (bf16_t*)(ws + ((l & 1) ? WS_XB1 : WS_XB0)); bf16_t* xb_nxt = (bf16_t*)(ws + ((l & 1) ? WS_XB0 : WS_XB1));
        float* ssq_cur = (float*)(ws + ((l & 1) ? WS_SSQ1 : WS_SSQ0)); float* ssq_nxt = (float*)(ws + ((l & 1) ? WS_SSQ0 : WS_SSQ1));

        if (INL(0)) for (int rep = 0; rep < NREP(1); ++rep) { const bool dry = rep + 1 < NREP(1); (void)dry;
            const FWin f{ssq_cur, z};
            { pg8::Gemm g{xb_cur, wl_ + WO_IN, MP, DIN, D, XLD, D}; pg8::StaticOrder S; S.init(MP, DIN, G, bx); const EpiP<FWin> E{f};
              pg8::gemm_phase<EpiP<FWin>, pg8::StaticOrder, true, true>(lds, g, S, E); }
            skinny_gemm<false>(lds, xb_cur, XLD, wl_ + WO_IN, D, DIN, D, f, nullptr, true);
        }
        SEAM(pbase + 0);

        if (INL(1)) for (int rep = 0; rep < NREP(2); ++rep) { const bool dry = rep + 1 < NREP(2); (void)dry;
            int lane_o = lane; asm volatile("" : "+v"(lane_o)); const int lane = lane_o; const int tid = wave * 64 + lane;
            LAS unsigned char* wlds = lds + wave * 4608;
            const float* sinks = args.in[21] + l * 8;
            for (int rb = 0; rb < NREPB(1u); ++rb) attn_phase_wg(z, obr, odil, lse, sinks, lds, bx, G);
        }

        if (INL(2)) for (int rep = 0; rep < NREP(3); ++rep) { const bool dry = rep + 1 < NREP(3); (void)dry;
            int lane_o = lane; asm volatile("" : "+v"(lane_o)); const int lane = lane_o;
            const int g_own = vcu & 31, b_own = vcu >> 5;
            {
              const int tid = wave * 64 + lane, fr = lane & 15, fq = lane >> 4; const bf16_t* Fall = (const bf16_t*)(sl + SO_F);
              for (int i = tid; i < 4096; i += NTHREADS) { const int row = i >> 5, c = i & 31; *(LAS u32x4*)(lds + C_T + row * 528 + c * 16) = *(const u32x4*)(Fall + (size_t)g_own * 32768 + row * 256 + c * 8); }
              __syncthreads();
#pragma unroll 1
              for (int uu = 0; uu < 2; ++uu) { const int ntl = wave * 2 + uu, cl = ntl * 16 + fr, n = (b_own * 16 + ntl) * 16 + fr;
                  const bf16_t* zu = z + (size_t)(16 * n + (fq >> 1)) * DIN + 16 * g_own + 8 * (fq & 1);
                  bf16x8 ub[8];
#pragma unroll
                  for (int s = 0; s < 8; ++s) ub[s] = *(const bf16x8*)(zu + (size_t)(2 * s) * DIN);
                  const LAS unsigned char* Fl = lds + C_T + fr * 528 + 16 * fq;
#pragma unroll
                  for (int mt = 0; mt < 8; ++mt) { f32x4 acc = {0.f, 0.f, 0.f, 0.f};
#pragma unroll
                      for (int s = 0; s < 8; ++s) acc = __builtin_amdgcn_mfma_f32_16x16x32_bf16(*(const LAS bf16x8*)(Fl + mt * 16 * 528 + 64 * s), ub[s], acc, 0, 0, 0);
                      u32x2 w; w.x = pk2(acc[0], acc[1]); w.y = pk2(acc[2], acc[3]); *(LAS u32x2*)(lds + C_ES + cl * C_ES_LD + (16 * mt + 4 * fq) * 2) = w;
                      __builtin_amdgcn_sched_barrier(0); }
              }
              __syncthreads();
            }
            if (wave == 0) {
              for (int rc = 0; rc < NREPC(1u); ++rc) { const int p = lane;
                const float* L16 = (const float*)(sl + SO_LAM16) + (g_own * 64 + p) * 2; const float lr = L16[0], li = L16[1];
                float sr = 0.f, si = 0.f;
                LAS unsigned char* es = lds + C_ES + 4 * p;
                unsigned eb[2][32];
#pragma unroll
                for (int i = 0; i < 32; ++i) eb[0][i] = *(const LAS unsigned*)(es + i * C_ES_LD);
#pragma unroll
                for (int blk = 0; blk < 8; ++blk) {
                    if (blk < 7) {
#pragma unroll
                        for (int i = 0; i < 32; ++i) eb[(blk + 1) & 1][i] = *(const LAS unsigned*)(es + (32 * (blk + 1) + i) * C_ES_LD); }
#pragma unroll
                    for (int i = 0; i < 32; ++i) { const unsigned e2 = eb[blk & 1][i];
                        if (rc + 1 == NREPC(1u)) *(LAS unsigned*)(es + (32 * blk + i) * C_ES_LD) = pk2(sr, si);
                        const float nr = lr * sr - li * si + bflo(e2), ni = lr * si + li * sr + bfhi(e2); sr = nr; si = ni; }
                    __builtin_amdgcn_sched_barrier(0);
                }
                float* so = args.out + O_SSMP + (((size_t)(l * 8 + b_own) * 32 + g_own) * 64 + p) * 2; so[0] = sr; so[1] = si; }
            } else {
              const int w7 = vcu * 7 + (wave - 1), NW7 = G * 7;
              LAS unsigned char* wlds = lds + C_WS + (wave - 1) * C_WS_SZ;
              const float* sinks = args.in[21] + l * 8;
              constexpr int NDILW = MS * 3; const int NOTH = NW7 - NDILW; const bool dilw = w7 >= NOTH;
              if (dilw) { const int u = w7 - NOTH; const int b = u / 3, gi = u % 3, sh = 2 * gi, W = 128 << sh; const bf16_t* zrow = z + (size_t)(MP + b) * DIN;
                  for (int rc = 0; rc < NREPC(2u); ++rc)
                  sample_dil_unit(zrow, ZC_DIL + 768 * gi, args.in[3 + gi] + ((size_t)(l * MS + b) * W) * 512, 1 << sh, odil + ((size_t)gi * MTP + MP + b) * 256, lse + ((size_t)gi * MTP + MP + b) * 4, wlds, lane); }
              else {
              const int gth7 = w7 * 64 + lane, NGT7 = NOTH * 64;
              for (int rc = 0; rc < NREPC(4u); ++rc)
              for (int v = w7; v < MS * 8; v += NOTH) { const int sub = lane & 15, kg = lane >> 4; const int b = v >> 3, h = v & 7, hk = h >> 2; const bf16_t* zrow = z + (size_t)(MP + b) * DIN;
                    const float* cache = args.in[2] + ((size_t)(l * MS + b) * 128) * 256 + hk * 64; f32x4 o; float lg;
                    sample_attn_core(zrow, ZC_QS + 64 * h, ZC_KS + 64 * hk, ZC_VS + 64 * hk, cache, 256, 128, 1, true, sinks[h] * LOG2E, wlds, lane, o, lg);
                    if (kg == 0) { u32x2 w; w.x = pk2(o[0], o[1]); w.y = pk2(o[2], o[3]); *(u32x2*)(obr + (size_t)(MP + b) * OBR_LD + 512 + 64 * h + 4 * sub) = w; }
              }
              { const float* LAM = (const float*)(sl + SO_LAM); const float* BBt = (const float*)(sl + SO_BB);
                for (int rc = 0; rc < NREPC(8u); ++rc)
                for (int u = w7; u < 32 * (MS / 4); u += NOTH) { const int g = u & 31, b0 = 4 * (u >> 5), p = lane;
                  const float lr = LAM[(g * 64 + p) * 2], li = LAM[(g * 64 + p) * 2 + 1];
                  f32x4 bb[8];
#pragma unroll
                  for (int i = 0; i < 8; ++i) bb[i] = *(const f32x4*)(BBt + (size_t)(g * 64 + p) * 32 + 4 * i);
                  const float* cre = args.in[16] + (size_t)(l * 32 + g) * 1024 + p; const float* cim = args.in[17] + (size_t)(l * 32 + g) * 1024 + p;
                  float cr[16], ci[16];
#pragma unroll
                  for (int hp = 0; hp < 16; ++hp) { cr[hp] = cre[hp * 64]; ci[hp] = cim[hp * 64]; }
                  const float dmine = args.in[18][l * 512 + g * 16 + (lane & 15)];
                  u32x4 w0[4], w1[4]; f32x2 h0v[4];
#pragma unroll
                  for (int j = 0; j < 4; ++j) { const size_t row = MP + b0 + j; w0[j] = *(const u32x4*)(z + row * DIN + 16 * g); w1[j] = *(const u32x4*)(z + row * DIN + 16 * g + 8);
                      h0v[j] = *(const f32x2*)(args.in[6] + (((size_t)(l * MS + b0 + j) * 32 + g) * 64 + p) * 2); }
#pragma unroll
                  for (int j = 0; j < 4; ++j) { const int b = b0 + j; const size_t row = MP + b;
                    float uu[16];
                    uu[0] = bflo(w0[j].x); uu[1] = bfhi(w0[j].x); uu[2] = bflo(w0[j].y); uu[3] = bfhi(w0[j].y); uu[4] = bflo(w0[j].z); uu[5] = bfhi(w0[j].z); uu[6] = bflo(w0[j].w); uu[7] = bfhi(w0[j].w);
                    uu[8] = bflo(w1[j].x); uu[9] = bfhi(w1[j].x); uu[10] = bflo(w1[j].y); uu[11] = bfhi(w1[j].y); uu[12] = bflo(w1[j].z); uu[13] = bfhi(w1[j].z); uu[14] = bflo(w1[j].w); uu[15] = bfhi(w1[j].w);
                    float sr = lr * h0v[j][0] - li * h0v[j][1], si = lr * h0v[j][1] + li * h0v[j][0];
#pragma unroll
                    for (int i = 0; i < 8; ++i) { sr += bb[i][0] * uu[2 * i] + bb[i][2] * uu[2 * i + 1]; si += bb[i][1] * uu[2 * i] + bb[i][3] * uu[2 * i + 1]; }
                    float* so = args.out + O_SSMS + (((size_t)(l * MS + b) * 32 + g) * 64 + p) * 2; *(f32x2*)so = (f32x2){sr, si};
                    float ymine = 0.f, umine = 0.f;
#pragma unroll
                    for (int hp = 0; hp < 16; ++hp) { const float v = wave_sum(cr[hp] * sr - ci[hp] * si); if (lane == hp) { ymine = v; umine = uu[hp]; } }
                    if (lane < 16) gact[row * 512 + 16 * g + lane] = f2bf(gelu_tanh(ymine + dmine * umine));
                  }
                } }
              for (int rc = 0; rc < NREPC(16u); ++rc)
              for (int seg = 0; seg < 8; ++seg) {
                int keep, nb, bstride, first, col0, W; size_t doff;
                if (seg < 4) { keep = (seg < 2) ? 128 : (seg == 2 ? 512 : 2048); const size_t dof = (seg == 0) ? O_SWAP : (seg == 1) ? O_D1P : (seg == 2) ? O_D4P : O_D16P; nb = 8; bstride = SEQ; first = SEQ - keep;
                    col0 = (seg == 0) ? ZC_KS : ZC_DIL + 768 * (seg - 1) + 256; W = (seg == 0) ? 256 : 512; doff = dof + (size_t)l * 8 * keep * W; }
                else { const size_t dof = (seg == 4) ? O_SWAS : (seg == 5) ? O_D1S : (seg == 6) ? O_D4S : O_D16S; keep = 1; nb = MS; bstride = 1; first = MP;
                    col0 = (seg == 4) ? ZC_KS : ZC_DIL + 768 * (seg - 5) + 256; W = (seg == 4) ? 256 : 512; doff = dof + (size_t)l * MS * W; }
                const int w8 = W / 8, nitems = nb * keep * w8;
#pragma unroll 4
                for (int it = gth7; it < nitems; it += NGT7) { const int r = it / w8, cc = it % w8, b = r / keep, t = r % keep;
                    f32x4 a, c; unpack8(*(const u32x4*)(z + (size_t)(b * bstride + first + t) * DIN + col0 + 8 * cc), a, c);
                    float* dst = args.out + doff + (size_t)r * W + 8 * cc; __builtin_nontemporal_store(a, (f32x4*)dst); __builtin_nontemporal_store(c, (f32x4*)(dst + 4)); }
              }
              }
            }
            __syncthreads();
            { const int tid = wave * 64 + lane;
            const bf16_t* KTall = (const bf16_t*)(sl + SO_KT); const bf16_t* GTall = (const bf16_t*)(sl + SO_GT); const int fr = lane & 15, fq = lane >> 4;
            LAS unsigned char* gtl = lds + C_T; LAS unsigned char* ktl = lds + C_T + 256 * 272;
            { const int g = g_own, bq = b_own;
                for (int i = tid; i < 4096; i += NTHREADS) { const int row = i >> 4, c = i & 15; *(LAS u32x4*)(gtl + row * 272 + c * 16) = *(const u32x4*)(GTall + (size_t)g * 32768 + row * 128 + c * 8); }
                { const int i = tid; *(LAS u32x4*)(ktl + i * 16) = *(const u32x4*)(KTall + (size_t)g * 4096 + i * 8); }
                __syncthreads();
#pragma unroll 1
                for (int uu = 0; uu < 2; ++uu) { const int ntl = wave * 2 + uu, cl = ntl * 16 + fr, nt = bq * 16 + ntl, n = nt * 16 + fr;
                    const bf16_t* zu = z + (size_t)(16 * n + (fq >> 1)) * DIN + 16 * g + 8 * (fq & 1);
                    bf16x8 ub[8], sb[4];
#pragma unroll
                    for (int s = 0; s < 8; ++s) ub[s] = *(const bf16x8*)(zu + (size_t)(2 * s) * DIN);
#pragma unroll
                    for (int s = 0; s < 4; ++s) sb[s] = *(const LAS bf16x8*)(lds + C_ES + cl * C_ES_LD + (32 * s + 8 * fq) * 2);
                    const LAS unsigned char* KTl = ktl + fr * 32 + 16 * (fq & 1); const int e = fq >> 1;
                    bf16x8 fe[8], fo[8];
#pragma unroll
                    for (int k = 0; k < 8; ++k) { const int lage = 2 * k - e, lago = 2 * k + 1 - e;
                        bf16x8 v = *(const LAS bf16x8*)(KTl + (lage < 0 ? 0 : lage) * 512); if (lage < 0) v = (bf16x8){0, 0, 0, 0, 0, 0, 0, 0}; fe[k] = v;
                        fo[k] = *(const LAS bf16x8*)(KTl + lago * 512); }
                    const LAS unsigned char* GTl = gtl + fr * 272 + 16 * fq;
#pragma unroll
                    for (int t = 0; t < 16; ++t) { f32x4 acc = {0.f, 0.f, 0.f, 0.f};
#pragma unroll
                        for (int s = 0; s <= t / 2; ++s) acc = __builtin_amdgcn_mfma_f32_16x16x32_bf16((t & 1) ? fo[t / 2 - s] : fe[t / 2 - s], ub[s], acc, 0, 0, 0);
#pragma unroll
                        for (int s = 0; s < 4; ++s) acc = __builtin_amdgcn_mfma_f32_16x16x32_bf16(*(const LAS bf16x8*)(GTl + t * 16 * 272 + 64 * s), sb[s], acc, 0, 0, 0);
                        u32x2 w; w.x = pk2(gelu_tanh(acc[0]), gelu_tanh(acc[1])); w.y = pk2(gelu_tanh(acc[2]), gelu_tanh(acc[3]));
                        *(u32x2*)(gact + (size_t)(16 * n + t) * 512 + 16 * g + 4 * fq) = w;
                        __builtin_amdgcn_sched_barrier(0); }
                }
            }
            }
            __syncthreads();
        }
        SEAM(pbase + 2);


        if (INL(4)) for (int rep = 0; rep < NREP(5); ++rep) { const bool dry = rep + 1 < NREP(5); (void)dry;
            { int lane_o = lane; asm volatile("" : "+v"(lane_o)); const int tid = wave * 64 + lane_o;
#pragma unroll 4
            for (int it = vcu * NTHREADS + tid; it < MT * 32; it += G * NTHREADS) { const int row = it >> 5, c8 = it & 31, h = c8 >> 3;
                const float l0 = lse[(size_t)row * 4 + h], l1 = lse[((size_t)MTP + row) * 4 + h], l2 = lse[((size_t)2 * MTP + row) * 4 + h];
                const float mx = fmaxf(l0, fmaxf(l1, l2)); float w0 = __expf(l0 - mx), w1 = __expf(l1 - mx), w2 = __expf(l2 - mx); const float inv = 1.f / (w0 + w1 + w2); w0 *= inv; w1 *= inv; w2 *= inv;
                f32x4 a0, b0, a1, b1, a2, b2;
                unpack8(*(const u32x4*)(odil + (size_t)row * 256 + 8 * c8), a0, b0); unpack8(*(const u32x4*)(odil + ((size_t)MTP + row) * 256 + 8 * c8), a1, b1); unpack8(*(const u32x4*)(odil + ((size_t)2 * MTP + row) * 256 + 8 * c8), a2, b2);
                *(u32x4*)(obr + (size_t)row * OBR_LD + 1024 + 8 * c8) = pack8(a0 * w0 + a1 * w1 + a2 * w2, b0 * w0 + b1 * w1 + b2 * w2); }
            }
            const FGlu f{gact, args.in[20] + l * 512, obr};
            { pg8::Gemm g{gact, wl_ + WO_GLU, MP, 512, 512, 512, 512}; pg8::StaticOrder S; S.init(MP, 512, G, bx); const EpiP<FGlu> E{f};
              pg8::gemm_phase<EpiP<FGlu>, pg8::StaticOrder, true, true>(lds, g, S, E); }
            skinny_gemm<false>(lds, gact, 512, wl_ + WO_GLU, 512, 512, 512, f, nullptr, true);
        }
        SEAM(pbase + 4);

        if (INL(5)) for (int rep = 0; rep < NREP(6); ++rep) { const bool dry = rep + 1 < NREP(6); (void)dry;
            { const FBr f{z, merged}; pg8::Gemm g{obr, wl_ + WO_BR, MP, D, 1280, OBR_LD, 1280}; pg8::StaticOrder S; S.init(MP, D, G, bx); const EpiP<FBr> E{f};
              pg8::gemm_phase<EpiP<FBr>, pg8::StaticOrder, true, true>(lds, g, S, E); }
            skinny_branches(lds, obr, wl_ + WO_BR, z, merged, wave);
        }
        SEAM(pbase + 5);

        if (INL(6)) for (int rep = 0; rep < NREP(7); ++rep) { const bool dry = rep + 1 < NREP(7); (void)dry;
            const FRes f{xb_cur, dry ? xbdum : xb_cur}; float* ssq_w = dry ? ssqdum : ssq_cur;
            { pg8::Gemm g{merged, wl_ + WO_OUT, MP, D, D, D, D}; pg8::StaticOrder S; S.init(MP, D, G, bx); const EpiR<FRes> E{f, ssq_w};
              pg8::gemm_phase<EpiR<FRes>, pg8::StaticOrder, true, true>(lds, g, S, E); }
            skinny_gemm<true>(lds, merged, D, wl_ + WO_OUT, D, D, D, f, ssq_w);
        }
        SEAM(pbase + 6);

        if (INL(7)) for (int rep = 0; rep < NREP(8); ++rep) { const bool dry = rep + 1 < NREP(8); (void)dry;
            const FUp f{ssq_cur, hid};
            { pg8::Gemm g{xb_cur, wl_ + WO_UP, MP, DFF, D, XLD, D}; pg8::StaticOrder S; S.init(MP, DFF, G, bx); const EpiP<FUp> E{f};
              pg8::gemm_phase<EpiP<FUp>, pg8::StaticOrder, true, true>(lds, g, S, E); }
            skinny_gemm<false>(lds, xb_cur, XLD, wl_ + WO_UP, D, DFF, D, f, nullptr, true);
        }
        SEAM(pbase + 7);

        if (INL(8)) for (int rep = 0; rep < NREP(9); ++rep) { const bool dry = rep + 1 < NREP(9); (void)dry;
            const FRes f{xb_cur, dry ? xbdum : xb_cur}; float* ssq_w = dry ? ssqdum : ssq_cur;
            { pg8::Gemm g{hid, wl_ + WO_DOWN, MP, D, DFF, DFF, DFF}; pg8::StaticOrder S; S.init(MP, D, G, bx); const EpiR<FRes> E{f, ssq_w};
              pg8::gemm_phase<EpiR<FRes>, pg8::StaticOrder, true, true>(lds, g, S, E); }
            skinny_gemm<true>(lds, hid, DFF, wl_ + WO_DOWN, DFF, D, DFF, f, ssq_w);
        }
        SEAM(pbase + 8);

        if (INL(9)) for (int rep = 0; rep < NREP(10); ++rep) { const bool dry = rep + 1 < NREP(10); (void)dry;
            bf16_t* xbw = dry ? xbdum : xb_nxt; float* ssq_w = dry ? ssqdum : ssq_nxt;
            { const FPgBig f{ssq_cur, ppb, xb_cur, xbw}; pg8::Gemm g{xb_cur, wl_ + WO_PGP, MP, D, 1280, XLD, 1280}; pg8::StaticOrder S; S.init(MP, D, G, bx); const EpiR<FPgBig> E{f, ssq_w};
              pg8::gemm_phase<EpiR<FPgBig>, pg8::StaticOrder, true, true>(lds, g, S, E); }
            skinny_ple(lds, xb_cur, wl_ + WO_PGP, ssq_cur, xbw, ssq_w);
        }
        SEAM(pbase + 9);
    }

    if (((PHM >> 11) & 1u) && IN(21)) for (int rep = 0; rep < NREP(11); ++rep) { const bool dry = rep + 1 < NREP(11);
        const float* gf = args.in[32]; const bf16_t* xfin = (const bf16_t*)(ws + WS_XB0);
        for (int m = gw; m < MT; m += NGW) {
            f32x4 v[4]; float s = 0.f;
#pragma unroll
            for (int j = 0; j < 4; ++j) { const u32x2 w = *(const u32x2*)(xfin + (size_t)m * XLD + 4 * lane + 256 * j); v[j] = (f32x4){bflo(w.x), bfhi(w.x), bflo(w.y), bfhi(w.y)};
                s += (v[j][0] * v[j][0] + v[j][1] * v[j][1]) + (v[j][2] * v[j][2] + v[j][3] * v[j][3]); }
            const float rs = rsqrtf(wave_sum(s) * (1.f / D) + EPS);
            float* yr = (dry ? (float*)(ws + WS_XDUM) : args.out) + (size_t)m * D;
#pragma unroll
            for (int j = 0; j < 4; ++j) { const f32x4 gg = *(const f32x4*)(gf + 4 * lane + 256 * j); __builtin_nontemporal_store(v[j] * rs * gg, (f32x4*)(yr + 4 * lane + 256 * j)); }
        }
    }
#undef IN
#undef SEAM
}

extern "C" void kernel_launch(void* const* d_in, const int* in_sizes, int n_in, void* d_out, int out_size, void* d_ws, size_t ws_size, hipStream_t stream) {
    static int grid = 0;
    if (grid == 0) {
        if (n_in != 33 || (size_t)out_size != O_END || ws_size < (REPM ? WS_END_PROBE : WS_END)) { fprintf(stderr, "kernel_launch: unexpected shapes: n_in %d out %d (want %zu) ws %zu (want %zu)\n", n_in, out_size, (size_t)O_END, ws_size, (size_t)WS_END); grid = -1; return; }
        int dev = 0, cus = 0;
        if (hipGetDevice(&dev) != hipSuccess || hipDeviceGetAttribute(&cus, hipDeviceAttributeMultiprocessorCount, dev) != hipSuccess) { grid = -1; return; }
        if (hipFuncSetAttribute((const void*)fwd_kernel, hipFuncAttributeMaxDynamicSharedMemorySize, LDS_BYTES) != hipSuccess) { fprintf(stderr, "kernel_launch: hipFuncSetAttribute failed\n"); grid = -1; return; }
        int per_cu = 0;
        if (hipOccupancyMaxActiveBlocksPerMultiprocessor(&per_cu, (const void*)fwd_kernel, NTHREADS, LDS_BYTES) != hipSuccess || per_cu < 1) fprintf(stderr, "kernel_launch: occupancy query says %d\n", per_cu);
        (void)hipGetLastError();
        if (cus < 256) { fprintf(stderr, "kernel_launch: built for a 256-CU device (one workgroup per (sequence, SSM group)); found %d CUs\n", cus); grid = -1; return; }
        grid = 256;
    }
    if (grid < 0) return;
    (void)hipMemsetAsync((char*)d_ws + WS_CTL, 0, CTL_BYTES, stream);
    Args a{};
    for (int i = 0; i < 33; ++i) a.in[i] = (const float*)d_in[i];
    a.out = (float*)d_out; a.ws = (unsigned char*)d_ws;
#if MK_ONE_LAUNCH
    a.ph_lo = 0; a.ph_hi = NPHASE;
    hipLaunchKernelGGL(fwd_kernel, dim3(grid), dim3(NTHREADS), LDS_BYTES, stream, a);
#else
    for (int p = 0; p < NPHASE; ++p) { a.ph_lo = p; a.ph_hi = p + 1; hipLaunchKernelGGL(fwd_kernel, dim3(grid), dim3(NTHREADS), LDS_BYTES, stream, a); }
#endif
}
```

```cpp
#include <hip/hip_runtime.h>
#include <cstdio>
#include <cstdint>

#ifndef MK_ONE_LAUNCH
#define MK_ONE_LAUNCH 1
#endif
#ifndef REPS
#define REPS 0
#endif

#define LAS __attribute__((address_space(3)))
#define GAS __attribute__((address_space(1)))
typedef unsigned short bf16_t;
typedef short bf16x8 __attribute__((ext_vector_type(8)));
typedef short s16x4 __attribute__((ext_vector_type(4)));
typedef float f32x4 __attribute__((ext_vector_type(4)));
typedef float f32x2 __attribute__((ext_vector_type(2)));
typedef float f32x16 __attribute__((ext_vector_type(16)));
typedef unsigned u32x4 __attribute__((ext_vector_type(4)));
typedef unsigned u32x2 __attribute__((ext_vector_type(2)));
typedef __bf16 bf16x2_t __attribute__((ext_vector_type(2)));

constexpr int D = 1024, NBATCH = 8, SEQ = 4096, MP = NBATCH * SEQ  , MS = 128  , MT = MP + MS, MTP = 33024;
constexpr int DIN = 6656, DFF = 4096, PLE = 256, NLAYER = 2;
constexpr int ZC_U = 0, ZC_QS = 512, ZC_KS = 1024, ZC_VS = 1152, ZC_DIL = 1280, ZC_GATE = 3584;
constexpr int NGRID = 256;
constexpr int OBR_LD = 1280;
constexpr int XLD = 1280;
constexpr float EPS = 1e-6f;
constexpr float LOG2E = 1.4426950408889634f, LN2 = 0.6931471805599453f;
constexpr float SCL2 = 0.125f * LOG2E;

constexpr size_t O_YP = 0, O_YS = O_YP + (size_t)MP * D, O_SWAP = O_YS + (size_t)MS * D, O_D1P = O_SWAP + 2ull * 8 * 128 * 256, O_D4P = O_D1P + 2ull * 8 * 128 * 512,
                 O_D16P = O_D4P + 2ull * 8 * 512 * 512, O_SSMP = O_D16P + 2ull * 8 * 2048 * 512, O_SWAS = O_SSMP + 2ull * 8 * 32 * 64 * 2, O_D1S = O_SWAS + 2ull * 128 * 256,
                 O_D4S = O_D1S + 2ull * 128 * 512, O_D16S = O_D4S + 2ull * 128 * 512, O_SSMS = O_D16S + 2ull * 128 * 512, O_END = O_SSMS + 2ull * 128 * 32 * 64 * 2;

constexpr size_t al(size_t x) { return (x + 4095) & ~(size_t)4095; }
constexpr size_t WS_CTL = 0, CTL_BYTES = 65536;
constexpr size_t WO_IN = 0, WO_GLU = WO_IN + (size_t)DIN * D, WO_BR = WO_GLU + 512 * 512  , WO_OUT = WO_BR + 1024 * 1280,
                 WO_UP = WO_OUT + 1024 * 1024, WO_DOWN = WO_UP + (size_t)DFF * D, WO_PGP = WO_DOWN + (size_t)D * DFF  , WL_ELEMS = WO_PGP + 1024 * 1280;
constexpr size_t WS_W = al(WS_CTL + CTL_BYTES), WL_BYTES = al(WL_ELEMS * 2);
constexpr size_t SO_KT = 0  , SO_GT = SO_KT + 32 * 4096 * 2  , SO_F = SO_GT + 32 * 16 * 16 * 128 * 2  ,
                 SO_LAM16 = SO_F + 32 * 128 * 256 * 2  , SO_LAM = SO_LAM16 + 32 * 64 * 2 * 4  , SO_BB = SO_LAM + 32 * 64 * 2 * 4  ,
                 SL_BYTES = al(SO_BB + 32 * 64 * 16 * 2 * 4);
constexpr size_t WS_SSM = WS_W + NLAYER * WL_BYTES;
constexpr size_t WS_XB0 = WS_SSM + NLAYER * SL_BYTES, XB_BYTES = al((size_t)MTP * XLD * 2);
constexpr size_t WS_XB1 = WS_XB0 + XB_BYTES;
constexpr size_t WS_SSQ0 = WS_XB1 + XB_BYTES, SSQ_BYTES = al((size_t)MTP * 16 * 4);
constexpr size_t WS_SSQ1 = WS_SSQ0 + SSQ_BYTES;
constexpr size_t WS_Z = WS_SSQ1 + SSQ_BYTES;
constexpr size_t WS_OBR = WS_Z + al((size_t)MTP * DIN * 2);
constexpr size_t WS_ODIL = WS_OBR + al((size_t)MTP * OBR_LD * 2);
constexpr size_t WS_LSE = WS_ODIL + al(3ull * MTP * 256 * 2);
constexpr size_t WS_E = WS_LSE + al(3ull * MTP * 4 * 4);
constexpr size_t WS_SIN = WS_E + al(2048ull * 32 * 128 * 4);
constexpr size_t WS_GACT = WS_SIN + al(2048ull * 32 * 128 * 2);
constexpr size_t WS_MERGED = WS_GACT + al((size_t)MTP * 512 * 2);
constexpr size_t WS_HID = WS_MERGED + al((size_t)MTP * D * 2);
constexpr size_t WS_PP = WS_HID + al((size_t)MTP * DFF * 2);
constexpr size_t WS_END = WS_PP + al((size_t)MTP * D * 2);
constexpr size_t WS_XDUM = WS_END, WS_XBDUM = WS_XDUM + al((size_t)MTP * D * 4), WS_SSQDUM = WS_XBDUM + XB_BYTES, WS_END_PROBE = WS_SSQDUM + SSQ_BYTES;

__device__ __forceinline__ float bf2f(bf16_t b) { return __uint_as_float((unsigned)b << 16); }
__device__ __forceinline__ float bflo(unsigned w) { return __uint_as_float(w << 16); }
__device__ __forceinline__ float bfhi(unsigned w) { return __uint_as_float(w & 0xffff0000u); }
__device__ __forceinline__ unsigned pk2(float lo, float hi) { f32x2 v = {lo, hi}; bf16x2_t b = __builtin_convertvector(v, bf16x2_t); return __builtin_bit_cast(unsigned, b); }
__device__ __forceinline__ bf16_t f2bf(float f) { return (bf16_t)(pk2(f, 0.f) & 0xffffu); }
__device__ __forceinline__ u32x4 pack8(f32x4 a, f32x4 b) { u32x4 w; w.x = pk2(a[0], a[1]); w.y = pk2(a[2], a[3]); w.z = pk2(b[0], b[1]); w.w = pk2(b[2], b[3]); return w; }
__device__ __forceinline__ void unpack8(u32x4 w, f32x4& a, f32x4& b) { a = (f32x4){bflo(w.x), bfhi(w.x), bflo(w.y), bfhi(w.y)}; b = (f32x4){bflo(w.z), bfhi(w.z), bflo(w.w), bfhi(w.w)}; }
__device__ __forceinline__ float sigmoidf_(float x) { return __builtin_amdgcn_rcpf(1.f + __builtin_amdgcn_exp2f(-LOG2E * x)); }
__device__ __forceinline__ float gelu_tanh(float x) { const float u = 0.7978845608028654f * (x + 0.044715f * x * x * x); return x * __builtin_amdgcn_rcpf(1.f + __builtin_amdgcn_exp2f(-2.f * LOG2E * u)); }
__device__ __forceinline__ float wave_sum(float v) {
#pragma unroll
    for (int o = 1; o < 64; o <<= 1) v += __shfl_xor(v, o);
    return v;
}
#define LDS_WAIT() asm volatile("s_waitcnt lgkmcnt(0)" ::: "memory")
#define VM_WAIT() asm volatile("s_waitcnt vmcnt(0)" ::: "memory")

namespace pg8 {
constexpr int BM = 256, BK = 64, HALF = 128, HTB = HALF * BK * 2, STAGE_BYTES = 8 * HTB, NXCD = 8, WGM = 4;
__host__ __device__ __forceinline__ int lds_byte(int r, int c) { const int st = (r >> 4) * 2 + (c >> 5), rr = r & 15, cc = c & 31, ob = rr * 64 + cc * 2; return st * 1024 + (ob ^ (((ob >> 9) & 1) << 5)); }
__host__ __device__ __forceinline__ void stage_rc(int b, int& R, int& C) { const int st = b / 1024, sb = b % 1024, swz = sb ^ (((sb >> 9) & 1) << 5); R = (st >> 1) * 16 + swz / 64; C = (st & 1) * 32 + (swz % 64) / 2; }
__host__ __device__ __forceinline__ int perm32(int rho) { const int n = rho >> 4, i = rho & 15; return 8 * (i >> 2) + 4 * n + (i & 3); }
struct Unit { int pm, pn, ord; };
struct Gemm { const bf16_t* A; const bf16_t* Bt; int M, N, K, lda, ldb; };
struct StaticOrder {
    int nM, nN, nwg, G, c;
    __host__ __device__ void init(int M, int N, int G_, int c_) { nM = M / BM; nN = N / BM; nwg = nM * nN; G = G_; c = c_; }
    __host__ __device__ bool next(int i, Unit& u) const {
        const long L = (long)i * G + c; if (L >= nwg) return false;
        int wgid = (int)L; { const int q = nwg / NXCD, r = nwg % NXCD, xcd = wgid % NXCD, off = wgid / NXCD; wgid = (xcd < r ? xcd * (q + 1) : r * (q + 1) + (xcd - r) * q) + off; }
        const int nig = WGM * nN, gid = wgid / nig, fm = gid * WGM, gsz = (nM - fm) < WGM ? (nM - fm) : WGM;
        u.pm = fm + ((wgid % nig) % gsz); u.pn = (wgid % nig) / gsz; u.ord = i; return true;
    }
    __device__ __forceinline__ void a_ready(const Unit&) const {}
    __device__ __forceinline__ void done(const Unit&) const {}
};

template <class Epi, class Sched, bool ALIGN_EPI = false, bool SP2 = false>
__device__ __forceinline__ void gemm_phase(LAS unsigned char* lds, const Gemm g, const Sched& S, const Epi& E) {
    int tid_ = threadIdx.x; asm volatile("" : "+v"(tid_));
    const int tid = tid_, wid = __builtin_amdgcn_readfirstlane(tid >> 6), lane = tid & 63, wr = wid >> 2, wc = wid & 3, fr = lane & 15, fq = lane >> 4;
    const int K = g.K, nt = K / BK, lda = g.lda, ldb = g.ldb;
    unsigned voffA[2], voffB[2];
#pragma unroll
    for (int i = 0; i < 2; ++i) { int R, C; stage_rc(tid * 16 + i * 8192, R, C); const int Rb = Epi::PERM ? ((R & ~31) + perm32(R & 31)) : R;
        voffA[i] = (unsigned)(R * lda + C) * 2u; voffB[i] = (unsigned)(Rb * ldb + C) * 2u; }
    const size_t kstep = (size_t)(BK * 2);
    const size_t hstepA = (size_t)HALF * lda * 2, hstepB = (size_t)HALF * ldb * 2;
    const size_t tstepA = 2 * hstepA, tstepB = 2 * hstepB;
    const unsigned ldsw = (unsigned)wid * 1024u;
    const int aoff = lds_byte(wr * 64 + fr, fq * 8), boff = lds_byte(wc * 32 + fr, fq * 8);
#define PG8_SA(b, h) (((b) * 2 + (h)) * HTB)
#define PG8_SB(b, h) ((4 + (b) * 2 + (h)) * HTB)
#define PG8_STAGE(bufoff, gbase, voff) do { _Pragma("unroll") for (int _i = 0; _i < 2; ++_i) \
        __builtin_amdgcn_global_load_lds((const unsigned*)((const char*)(gbase) + (voff)[_i]), (LAS unsigned*)(lds + (bufoff) + ldsw + _i * 8192), 16, 0, 0); } while (0)
#define PG8_LDA(dst, b, h) do { _Pragma("unroll") for (int m = 0; m < 4; ++m) _Pragma("unroll") for (int k = 0; k < 2; ++k) dst[m][k] = *(const LAS bf16x8*)(lds + PG8_SA(b, h) + aoff + m * 2048 + k * 1024); } while (0)
#define PG8_LDB(dst, b, h) do { _Pragma("unroll") for (int n = 0; n < 2; ++n) _Pragma("unroll") for (int k = 0; k < 2; ++k) dst[n][k] = *(const LAS bf16x8*)(lds + PG8_SB(b, h) + boff + n * 2048 + k * 1024); } while (0)
#define PG8_MMA(ai, bj, At, Bt) do { __builtin_amdgcn_s_setprio(1); _Pragma("unroll") for (int m = 0; m < 4; ++m) _Pragma("unroll") for (int n = 0; n < 2; ++n) _Pragma("unroll") for (int k = 0; k < 2; ++k) \
        acc[ai][bj][m][n] = __builtin_amdgcn_mfma_f32_16x16x32_bf16(Bt[n][k], At[m][k], acc[ai][bj][m][n], 0, 0, 0); __builtin_amdgcn_s_setprio(0); } while (0)
#define PG8_WAIT_V(n) asm volatile("s_waitcnt vmcnt(" #n ")" ::: "memory")
#define PG8_WAIT_L(n) asm volatile("s_waitcnt lgkmcnt(" #n ")" ::: "memory")
#define PG8_BAR __builtin_amdgcn_s_barrier()
#define PG8_SCHED __builtin_amdgcn_sched_barrier(0)
    Unit cur, nxt; int ui = 0;
    if (!S.next(0, cur)) return;
    f32x4 acc[2][2][4][2];
#pragma unroll
    for (int a = 0; a < 2; ++a)
#pragma unroll
        for (int b = 0; b < 2; ++b)
#pragma unroll
            for (int m = 0; m < 4; ++m)
#pragma unroll
                for (int n = 0; n < 2; ++n) acc[a][b][m][n] = (f32x4){0.f, 0.f, 0.f, 0.f};
    bf16x8 At[4][2], B0[2][2], B1[2][2];
    const char* cA = (const char*)g.A + (size_t)cur.pm * tstepA; const char* cB = (const char*)g.Bt + (size_t)cur.pn * tstepB;
    S.a_ready(cur);
    if constexpr (SP2) {
        PG8_STAGE(PG8_SB(0, 0), cB, voffB); PG8_STAGE(PG8_SB(0, 1), cB + hstepB, voffB); PG8_STAGE(PG8_SA(0, 0), cA, voffA); PG8_STAGE(PG8_SA(0, 1), cA + hstepA, voffA);
        if (wr == 1) PG8_BAR;
        PG8_WAIT_V(2); PG8_BAR;
        PG8_STAGE(PG8_SB(1, 0), cB + kstep, voffB); PG8_STAGE(PG8_SA(1, 0), cA + kstep, voffA); PG8_STAGE(PG8_SB(1, 1), cB + hstepB + kstep, voffB);
        PG8_WAIT_V(6); PG8_BAR;
    } else {
        PG8_STAGE(PG8_SB(0, 0), cB, voffB); PG8_STAGE(PG8_SA(0, 0), cA, voffA); PG8_STAGE(PG8_SB(0, 1), cB + hstepB, voffB); PG8_STAGE(PG8_SA(0, 1), cA + hstepA, voffA);
        if (wr == 1) PG8_BAR;
        PG8_WAIT_V(4); PG8_BAR;
        PG8_STAGE(PG8_SB(1, 0), cB + kstep, voffB); PG8_STAGE(PG8_SA(1, 0), cA + kstep, voffA); PG8_STAGE(PG8_SB(1, 1), cB + hstepB + kstep, voffB);
        PG8_WAIT_V(6); PG8_BAR;
    }
    for (;;) {
        const bool has_next = S.next(ui + 1, nxt);
        const char* nA = has_next ? (const char*)g.A + (size_t)nxt.pm * tstepA : cA; const char* nB = has_next ? (const char*)g.Bt + (size_t)nxt.pn * tstepB : cB;
        for (int t = 0; t < nt; t += 2) {
            if constexpr (Epi::FLUSH) { if (E.is_flush(t)) { if constexpr (ALIGN_EPI) { if (wr == 0) PG8_BAR; }
                Unit uu = cur; { int oz = 0; asm volatile("" : "+s"(oz)); uu.pm += oz; }
                E.flush(acc, uu, t, wr, wc, fr, fq);
                if constexpr (!Epi::KEEP) {
#pragma unroll
                for (int a = 0; a < 2; ++a)
#pragma unroll
                    for (int b = 0; b < 2; ++b)
#pragma unroll
                        for (int m = 0; m < 4; ++m)
#pragma unroll
                            for (int n = 0; n < 2; ++n) acc[a][b][m][n] = (f32x4){0.f, 0.f, 0.f, 0.f}; }
                if constexpr (ALIGN_EPI) { if (wr == 1) PG8_BAR; } } }
            const bool last = (t == nt - 2);
            const char* a1 = cA + (size_t)(t + 1) * kstep;
            const char* a2 = last ? nA : cA + (size_t)(t + 2) * kstep; const char* b2 = last ? nB : cB + (size_t)(t + 2) * kstep;
            const char* a3 = a2 + kstep; const char* b3 = b2 + kstep;
            if (last && has_next) S.a_ready(nxt);
            if constexpr (SP2) {
            PG8_LDB(B0, 0, 0); PG8_LDB(B1, 0, 1); PG8_SCHED; PG8_LDA(At, 0, 0); PG8_STAGE(PG8_SA(1, 1), a1 + hstepA, voffA);
            PG8_WAIT_V(8); PG8_WAIT_L(0); PG8_BAR; PG8_MMA(0, 0, At, B0); PG8_MMA(0, 1, At, B1); PG8_BAR; PG8_SCHED;
            PG8_LDA(At, 0, 1); PG8_STAGE(PG8_SB(0, 0), b2, voffB); PG8_STAGE(PG8_SB(0, 1), b2 + hstepB, voffB); PG8_STAGE(PG8_SA(0, 0), a2, voffA);
            PG8_WAIT_V(8); PG8_WAIT_L(0); PG8_BAR; PG8_MMA(1, 0, At, B0); PG8_MMA(1, 1, At, B1); PG8_BAR; PG8_SCHED;
            PG8_LDB(B0, 1, 0); PG8_LDB(B1, 1, 1); PG8_SCHED; PG8_LDA(At, 1, 0); PG8_STAGE(PG8_SA(0, 1), a2 + hstepA, voffA);
            PG8_WAIT_V(8); PG8_WAIT_L(0); PG8_BAR; PG8_MMA(0, 0, At, B0); PG8_MMA(0, 1, At, B1); PG8_BAR; PG8_SCHED;
            PG8_LDA(At, 1, 1); PG8_STAGE(PG8_SB(1, 0), b3, voffB); PG8_STAGE(PG8_SB(1, 1), b3 + hstepB, voffB); PG8_STAGE(PG8_SA(1, 0), a3, voffA);
            PG8_WAIT_V(8); PG8_WAIT_L(0); PG8_BAR; PG8_MMA(1, 0, At, B0); PG8_MMA(1, 1, At, B1); PG8_BAR; PG8_SCHED;
            } else {
            PG8_LDB(B0, 0, 0); PG8_SCHED; PG8_LDA(At, 0, 0); PG8_STAGE(PG8_SA(1, 1), a1 + hstepA, voffA);
            PG8_WAIT_L(8); PG8_BAR; PG8_WAIT_L(0); PG8_MMA(0, 0, At, B0); PG8_BAR; PG8_SCHED;
            PG8_LDB(B1, 0, 1); PG8_STAGE(PG8_SB(0, 0), b2, voffB);
            PG8_BAR; PG8_WAIT_L(0); PG8_MMA(0, 1, At, B1); PG8_BAR;
            PG8_LDA(At, 0, 1); PG8_STAGE(PG8_SA(0, 0), a2, voffA);
            PG8_BAR; PG8_WAIT_L(0); PG8_MMA(1, 0, At, B0); PG8_BAR; PG8_SCHED;
            PG8_STAGE(PG8_SB(0, 1), b2 + hstepB, voffB);
            PG8_WAIT_V(6); PG8_BAR; PG8_MMA(1, 1, At, B1); PG8_BAR;
            PG8_LDB(B0, 1, 0); PG8_SCHED; PG8_LDA(At, 1, 0); PG8_STAGE(PG8_SA(0, 1), a2 + hstepA, voffA);
            PG8_WAIT_L(8); PG8_BAR; PG8_WAIT_L(0); PG8_MMA(0, 0, At, B0); PG8_BAR; PG8_SCHED;
            PG8_LDB(B1, 1, 1); PG8_STAGE(PG8_SB(1, 0), b3, voffB);
            PG8_BAR; PG8_WAIT_L(0); PG8_MMA(0, 1, At, B1); PG8_BAR;
            PG8_LDA(At, 1, 1); PG8_STAGE(PG8_SA(1, 0), a3, voffA);
            PG8_BAR; PG8_WAIT_L(0); PG8_MMA(1, 0, At, B0); PG8_BAR; PG8_SCHED;
            PG8_STAGE(PG8_SB(1, 1), b3 + hstepB, voffB);
            PG8_WAIT_V(6); PG8_BAR; PG8_MMA(1, 1, At, B1); PG8_BAR;
            }
        }
        if constexpr (ALIGN_EPI) { if (wr == 0) PG8_BAR; }
        E(acc, cur, wr, wc, fr, fq); S.done(cur);
        if (!has_next) break;
#pragma unroll
        for (int a = 0; a < 2; ++a)
#pragma unroll
            for (int b = 0; b < 2; ++b)
#pragma unroll
                for (int m = 0; m < 4; ++m)
#pragma unroll
                    for (int n = 0; n < 2; ++n) acc[a][b][m][n] = (f32x4){0.f, 0.f, 0.f, 0.f};
        cur = nxt; cA = nA; cB = nB; ++ui;
        if constexpr (ALIGN_EPI) { if (wr == 1) PG8_BAR; }
    }
    PG8_WAIT_V(0);
    if constexpr (!ALIGN_EPI) { if (wr == 0) PG8_BAR; }
    PG8_BAR;
#undef PG8_SA
#undef PG8_SB
#undef PG8_STAGE
#undef PG8_LDA
#undef PG8_LDB
#undef PG8_MMA
#undef PG8_WAIT_V
#undef PG8_WAIT_L
#undef PG8_BAR
#undef PG8_SCHED
}
}

__device__ __forceinline__ float row_rstd(const float* ssq, int row, int fq) {
    const f32x4 p = *(const f32x4*)(ssq + (size_t)row * 16 + 4 * fq);
    float s = (p[0] + p[1]) + (p[2] + p[3]);
    s += __shfl_xor(s, 16); s += __shfl_xor(s, 32);
    return rsqrtf(s * (1.f / D) + EPS);
}
struct FWin { static constexpr bool FLUSH = false, KEEP = false; const float* ssq; bf16_t* z; const LAS float* rtab;
    __device__ __forceinline__ float ctx(int row, int fq) const { return row_rstd(ssq, row, fq); }
    __device__ __forceinline__ float ctxl(const pg8::Unit& u, int row, int) const { return rtab[u.ord * 256 + (row & 255)]; }
    __device__ __forceinline__ void operator()(int row, int col, float rs, f32x4 v0, f32x4 v1) const { __builtin_nontemporal_store(pack8(v0 * rs, v1 * rs), (u32x4*)(z + (size_t)row * DIN + col)); } };
struct FGlu { static constexpr bool FLUSH = false, KEEP = false; const bf16_t* gact; const float* bias; bf16_t* obr;
    __device__ __forceinline__ float ctx(int, int) const { return 0.f; }
    __device__ __forceinline__ float ctxl(const pg8::Unit&, int, int) const { return 0.f; }
    __device__ __forceinline__ void operator()(int row, int col, float, f32x4 v0, f32x4 v1) const {
        f32x4 g0, g1; unpack8(*(const u32x4*)(gact + (size_t)row * 512 + col), g0, g1);
        const f32x4 b0 = *(const f32x4*)(bias + col), b1 = *(const f32x4*)(bias + col + 4);
#pragma unroll
        for (int i = 0; i < 4; ++i) { g0[i] *= sigmoidf_(v0[i] + b0[i]); g1[i] *= sigmoidf_(v1[i] + b1[i]); }
        *(u32x4*)(obr + (size_t)row * OBR_LD + col) = pack8(g0, g1); } };
template <bool FIRST> struct FBranch { static constexpr bool FLUSH = false, KEEP = false; const bf16_t* zgate; bf16_t* merged;
    __device__ __forceinline__ float ctx(int, int) const { return 0.f; }
    __device__ __forceinline__ float ctxl(const pg8::Unit&, int, int) const { return 0.f; }
    __device__ __forceinline__ void operator()(int row, int col, float, f32x4 v0, f32x4 v1) const {
        f32x4 g0, g1; unpack8(*(const u32x4*)(zgate + (size_t)row * DIN + col), g0, g1);
        f32x4 m0 = {0.f, 0.f, 0.f, 0.f}, m1 = {0.f, 0.f, 0.f, 0.f};
        if (!FIRST) unpack8(*(const u32x4*)(merged + (size_t)row * D + col), m0, m1);
#pragma unroll
        for (int i = 0; i < 4; ++i) { m0[i] += sigmoidf_(g0[i]) * v0[i]; m1[i] += sigmoidf_(g1[i]) * v1[i]; }
        *(u32x4*)(merged + (size_t)row * D + col) = pack8(m0, m1); } };
struct FUp { static constexpr bool FLUSH = false, KEEP = false; const float* ssq; bf16_t* hid; const LAS float* rtab;
    __device__ __forceinline__ float ctx(int row, int fq) const { return row_rstd(ssq, row, fq); }
    __device__ __forceinline__ float ctxl(const pg8::Unit& u, int row, int) const { return rtab[u.ord * 256 + (row & 255)]; }
    __device__ __forceinline__ void operator()(int row, int col, float rs, f32x4 v0, f32x4 v1) const {
#pragma unroll
        for (int i = 0; i < 4; ++i) { float a = fmaxf(v0[i] * rs, 0.f), b = fmaxf(v1[i] * rs, 0.f); v0[i] = a * a; v1[i] = b * b; }
        __builtin_nontemporal_store(pack8(v0, v1), (u32x4*)(hid + (size_t)row * DFF + col)); } };
struct FPp { static constexpr bool FLUSH = false, KEEP = false; bf16_t* pp;
    __device__ __forceinline__ float ctx(int, int) const { return 0.f; }
    __device__ __forceinline__ float ctxl(const pg8::Unit&, int, int) const { return 0.f; }
    __device__ __forceinline__ void operator()(int row, int col, float, f32x4 v0, f32x4 v1) const { *(u32x4*)(pp + (size_t)row * D + col) = pack8(v0, v1); } };
__device__ __forceinline__ float sig_ratio(float gn, float gd) {
    gn = __builtin_amdgcn_fmed3f(gn, -30.f, 30.f); gd = __builtin_amdgcn_fmed3f(gd, -30.f, 30.f);
    return (1.f + __builtin_amdgcn_exp2f(-LOG2E * gd)) * __builtin_amdgcn_rcpf(1.f + __builtin_amdgcn_exp2f(-LOG2E * gn)); }
struct FBr { static constexpr bool FLUSH = true, KEEP = true; const bf16_t* z; bf16_t* merged;
    __device__ __forceinline__ float ctx(int, int) const { return 0.f; }
    __device__ __forceinline__ float ctxl(const pg8::Unit&, int, int) const { return 0.f; }
    __device__ __forceinline__ bool is_flush(int t) const { return t == 8 || t == 16; }
    __device__ __forceinline__ void flush(int t, int row, int col, float, f32x4& v0, f32x4& v1) const {
        const int gc = (t == 8) ? ZC_GATE : ZC_GATE + 1024;
        f32x4 n0, n1, d0, d1; unpack8(__builtin_nontemporal_load((const u32x4*)(z + (size_t)row * DIN + gc + col)), n0, n1); unpack8(*(const u32x4*)(z + (size_t)row * DIN + gc + 1024 + col), d0, d1);
#pragma unroll
        for (int i = 0; i < 4; ++i) { v0[i] *= sig_ratio(n0[i], d0[i]); v1[i] *= sig_ratio(n1[i], d1[i]); } }
    __device__ __forceinline__ void operator()(int row, int col, float, f32x4 v0, f32x4 v1) const {
        f32x4 g0, g1; unpack8(__builtin_nontemporal_load((const u32x4*)(z + (size_t)row * DIN + ZC_GATE + 2048 + col)), g0, g1);
#pragma unroll
        for (int i = 0; i < 4; ++i) { v0[i] *= sigmoidf_(g0[i]); v1[i] *= sigmoidf_(g1[i]); }
        *(u32x4*)(merged + (size_t)row * D + col) = pack8(v0, v1); } };
__device__ __forceinline__ float sumsq8(f32x4 a, f32x4 b) { return ((a[0] * a[0] + a[1] * a[1]) + (a[2] * a[2] + a[3] * a[3])) + ((b[0] * b[0] + b[1] * b[1]) + (b[2] * b[2] + b[3] * b[3])); }
struct FRes { static constexpr bool FLUSH = false, KEEP = false; const bf16_t* xin; bf16_t* xout;
    __device__ __forceinline__ float ctx(int, int) const { return 0.f; }
    __device__ __forceinline__ float ctxl(const pg8::Unit&, int, int) const { return 0.f; }
    __device__ __forceinline__ float operator()(int row, int col, float, f32x4 v0, f32x4 v1) const {
        f32x4 x0, x1; unpack8(*(const u32x4*)(xin + (size_t)row * XLD + col), x0, x1); x0 += v0; x1 += v1;
        *(u32x4*)(xout + (size_t)row * XLD + col) = pack8(x0, x1); return sumsq8(x0, x1); } };
struct FPg { static constexpr bool FLUSH = false, KEEP = false; const float* ssq; const bf16_t* pp; const bf16_t* xin; bf16_t* xout; const LAS float* rtab;
    __device__ __forceinline__ float ctx(int row, int fq) const { return row_rstd(ssq, row, fq); }
    __device__ __forceinline__ float ctxl(const pg8::Unit& u, int row, int) const { return rtab[u.ord * 256 + (row & 255)]; }
    __device__ __forceinline__ float operator()(int row, int col, float rs, f32x4 v0, f32x4 v1) const {
        f32x4 p0, p1, x0, x1; unpack8(*(const u32x4*)(pp + (size_t)row * D + col), p0, p1); unpack8(*(const u32x4*)(xin + (size_t)row * XLD + col), x0, x1);
#pragma unroll
        for (int i = 0; i < 4; ++i) { x0[i] += sigmoidf_(v0[i] * rs) * p0[i]; x1[i] += sigmoidf_(v1[i] * rs) * p1[i]; }
        *(u32x4*)(xout + (size_t)row * XLD + col) = pack8(x0, x1); return sumsq8(x0, x1); } };
struct FPgBig { static constexpr bool FLUSH = true, KEEP = false; const float* ssq; bf16_t* gb; const bf16_t* xin; bf16_t* xout; const LAS float* rtab;
    __device__ __forceinline__ float ctx(int row, int fq) const { return row_rstd(ssq, row, fq); }
    __device__ __forceinline__ float ctxl(const pg8::Unit& u, int row, int) const { return rtab[u.ord * 256 + (row & 255)]; }
    __device__ __forceinline__ bool is_flush(int t) const { return t == 16; }
    __device__ __forceinline__ void flush(int, int row, int col, float rs, f32x4& a0, f32x4& a1) const { f32x4 v0 = a0, v1 = a1;
#pragma unroll
        for (int i = 0; i < 4; ++i) { v0[i] = sigmoidf_(v0[i] * rs); v1[i] = sigmoidf_(v1[i] * rs); }
        *(u32x4*)(gb + (size_t)row * D + col) = pack8(v0, v1); }
    __device__ __forceinline__ float operator()(int row, int col, float, f32x4 v0, f32x4 v1) const {
        f32x4 g0, g1, x0, x1; unpack8(*(const u32x4*)(gb + (size_t)row * D + col), g0, g1); unpack8(*(const u32x4*)(xin + (size_t)row * XLD + col), x0, x1);
        x0 += g0 * v0; x1 += g1 * v1;
        *(u32x4*)(xout + (size_t)row * XLD + col) = pack8(x0, x1); return sumsq8(x0, x1); } };

template <class F> struct EpiP { static constexpr bool PERM = true, FLUSH = F::FLUSH, KEEP = F::KEEP; F f;
    template <bool FL, class ACC> __device__ __forceinline__ void run(ACC& acc, const pg8::Unit& u, int t, int wr, int wc, int fr, int fq) const {
#pragma unroll
        for (int ai = 0; ai < 2; ++ai)
#pragma unroll
            for (int m = 0; m < 4; ++m) { const int row = u.pm * 256 + ai * 128 + wr * 64 + m * 16 + fr; const float c = f.ctxl(u, row, fq);
#pragma unroll
                for (int bj = 0; bj < 2; ++bj) { const int col = u.pn * 256 + bj * 128 + wc * 32 + 8 * fq;
                    if constexpr (FL) f.flush(t, row, col, c, acc[ai][bj][m][0], acc[ai][bj][m][1]); else f(row, col, c, acc[ai][bj][m][0], acc[ai][bj][m][1]); }
                if (m == 3) asm volatile("" ::: "memory"); } }
    __device__ __forceinline__ void operator()(const f32x4 (&acc)[2][2][4][2], const pg8::Unit& u, int wr, int wc, int fr, int fq) const { run<false>(acc, u, 0, wr, wc, fr, fq); }
    __device__ __forceinline__ bool is_flush(int t) const { return f.is_flush(t); }
    __device__ __forceinline__ void flush(f32x4 (&acc)[2][2][4][2], const pg8::Unit& u, int t, int wr, int wc, int fr, int fq) const { run<true>(acc, u, t, wr, wc, fr, fq); } };
template <class F> struct EpiR { static constexpr bool PERM = true, FLUSH = F::FLUSH, KEEP = F::KEEP; F f; float* ssq_out;
    template <bool FL, class ACC> __device__ __forceinline__ void run(ACC& acc, const pg8::Unit& u, int t, int wr, int wc, int fr, int fq) const {
#pragma unroll
        for (int ai = 0; ai < 2; ++ai)
#pragma unroll
            for (int m = 0; m < 4; ++m) { const int row = u.pm * 256 + ai * 128 + wr * 64 + m * 16 + fr; const float c = f.ctxl(u, row, fq); float sq = 0.f;
#pragma unroll
                for (int bj = 0; bj < 2; ++bj) { const int col = u.pn * 256 + bj * 128 + wc * 32 + 8 * fq;
                    if constexpr (FL) f.flush(t, row, col, c, acc[ai][bj][m][0], acc[ai][bj][m][1]); else sq += f(row, col, c, acc[ai][bj][m][0], acc[ai][bj][m][1]); }
                if constexpr (!FL) { sq += __shfl_xor(sq, 16); sq += __shfl_xor(sq, 32);
                    if (fq == 0) ssq_out[(size_t)row * 16 + u.pn * 4 + wc] = sq; }
                if (m == 3) asm volatile("" ::: "memory"); } }
    __device__ __forceinline__ void operator()(const f32x4 (&acc)[2][2][4][2], const pg8::Unit& u, int wr, int wc, int fr, int fq) const { run<false>(acc, u, 0, wr, wc, fr, fq); }
    __device__ __forceinline__ bool is_flush(int t) const { return f.is_flush(t); }
    __device__ __forceinline__ void flush(f32x4 (&acc)[2][2][4][2], const pg8::Unit& u, int t, int wr, int wc, int fr, int fq) const { run<true>(acc, u, t, wr, wc, fr, fq); } };

template <bool RES, class F>
__device__ __forceinline__ void skinny_gemm(LAS unsigned char* lds, const bf16_t* A, int lda, const bf16_t* Bt, int ldb, int N, int K, const F& f, float* ssq_out, bool idem = false, int it_lo = 0, int it_hi = 1 << 30) {
    int tid_ = threadIdx.x; asm volatile("" : "+v"(tid_));
    const int tid = tid_, wid = __builtin_amdgcn_readfirstlane(tid >> 6), lane = tid & 63, fr = lane & 15, fq = lane >> 4; (void)tid;
    const int nunits = 8 * (N / 64), G = NGRID, kw = K / 8;
    for (int rs = 0; rs < ((REPS && idem) ? 2 : 1); ++rs) {
    for (int u = (int)((blockIdx.x % 8u) * (NGRID / 8) + blockIdx.x / 8u) + it_lo * G, it = it_lo; u < nunits && it < it_hi; u += G, ++it) {
        LAS f32x4* part = (LAS f32x4*)lds + (it & 1) * (8 * 4 * 64);
        const int rt = u & 7, cg = u >> 3, row0 = MP + 16 * rt, col0 = 64 * cg;
        const bf16_t* ap = A + (size_t)(row0 + fr) * lda + wid * kw + 8 * fq;
        const bf16_t* bp[4];
#pragma unroll
        for (int n = 0; n < 4; ++n) bp[n] = Bt + (size_t)(col0 + 32 * (n >> 1) + 8 * (fr >> 2) + 4 * (n & 1) + (fr & 3)) * ldb + wid * kw + 8 * fq;
        f32x4 acc[4];
#pragma unroll
        for (int n = 0; n < 4; ++n) acc[n] = (f32x4){0.f, 0.f, 0.f, 0.f};
#pragma unroll 4
        for (int k = 0; k < kw; k += 32) { const bf16x8 a = *(const bf16x8*)(ap + k);
#pragma unroll
            for (int n = 0; n < 4; ++n) acc[n] = __builtin_amdgcn_mfma_f32_16x16x32_bf16(*(const bf16x8*)(bp[n] + k), a, acc[n], 0, 0, 0); }
#pragma unroll
        for (int n = 0; n < 4; ++n) part[(wid * 4 + n) * 64 + lane] = acc[n];
        __syncthreads();
        if (wid == (it & 7)) {
#pragma unroll
            for (int n = 0; n < 4; ++n) { f32x4 sacc = part[n * 64 + lane];
#pragma unroll
                for (int w = 1; w < 8; ++w) sacc += part[(w * 4 + n) * 64 + lane];
                acc[n] = sacc; }
            const int row = row0 + fr; const float c = f.ctx(row, fq);
            if constexpr (RES) { float sq = 0.f;
#pragma unroll
                for (int gq = 0; gq < 2; ++gq) sq += f(row, col0 + 32 * gq + 8 * fq, c, acc[2 * gq], acc[2 * gq + 1]);
                sq += __shfl_xor(sq, 16); sq += __shfl_xor(sq, 32);
                if (fq == 0) ssq_out[(size_t)row * 16 + cg] = sq;
            } else {
#pragma unroll
                for (int gq = 0; gq < 2; ++gq) f(row, col0 + 32 * gq + 8 * fq, c, acc[2 * gq], acc[2 * gq + 1]);
            }
        }
    }
    __syncthreads(); }
}

__device__ __forceinline__ void skinny_branches(LAS unsigned char* lds, const bf16_t* A  , const bf16_t* Bt  , const bf16_t* z, bf16_t* merged, int wave_) {
    int tid_ = threadIdx.x; asm volatile("" : "+v"(tid_)); (void)wave_;
    const int wid = __builtin_amdgcn_readfirstlane(tid_ >> 6), lane = tid_ & 63, fr = lane & 15, fq = lane >> 4;
    const int br = wid < 3 ? 0 : (wid < 6 ? 1 : 2), wi = wid - (br == 0 ? 0 : br == 1 ? 3 : 6);
    const int s0 = br == 2 ? 32 + 4 * wi : 16 * br + (wi == 0 ? 0 : wi == 1 ? 6 : 11), s1 = br == 2 ? s0 + 4 : 16 * br + (wi == 0 ? 6 : wi == 1 ? 11 : 16);
    LAS f32x4* part = (LAS f32x4*)lds;
    const int G = NGRID;
    for (int u = (int)((blockIdx.x % 8u) * (NGRID / 8) + blockIdx.x / 8u); u < 8 * (D / 64); u += G) {
        const int rt = u & 7, cg = u >> 3, row0 = MP + 16 * rt, col0 = 64 * cg;
        const bf16_t* ap = A + (size_t)(row0 + fr) * OBR_LD + 8 * fq;
        const bf16_t* bp[4];
#pragma unroll
        for (int n = 0; n < 4; ++n) bp[n] = Bt + (size_t)(col0 + 32 * (n >> 1) + 8 * (fr >> 2) + 4 * (n & 1) + (fr & 3)) * 1280 + 8 * fq;
        f32x4 acc[4];
#pragma unroll
        for (int n = 0; n < 4; ++n) acc[n] = (f32x4){0.f, 0.f, 0.f, 0.f};
#pragma unroll 6
        for (int st = s0; st < s1; ++st) { const bf16x8 a = *(const bf16x8*)(ap + 32 * st);
#pragma unroll
            for (int n = 0; n < 4; ++n) acc[n] = __builtin_amdgcn_mfma_f32_16x16x32_bf16(*(const bf16x8*)(bp[n] + 32 * st), a, acc[n], 0, 0, 0); }
#pragma unroll
        for (int n = 0; n < 4; ++n) part[(wid * 4 + n) * 64 + lane] = acc[n];
        __syncthreads();
        if (wid == 0) { const int row = row0 + fr;
#pragma unroll
            for (int gq = 0; gq < 2; ++gq) { const int col = col0 + 32 * gq + 8 * fq; f32x4 m0 = {0.f, 0.f, 0.f, 0.f}, m1 = m0;
#pragma unroll
                for (int b3 = 0; b3 < 3; ++b3) { const int w0 = b3 == 0 ? 0 : b3 == 1 ? 3 : 6, nw = b3 == 2 ? 2 : 3;
                    f32x4 s0v = part[(w0 * 4 + 2 * gq) * 64 + lane], s1v = part[(w0 * 4 + 2 * gq + 1) * 64 + lane];
#pragma unroll
                    for (int w = 1; w < 3; ++w) if (w < nw) { s0v += part[((w0 + w) * 4 + 2 * gq) * 64 + lane]; s1v += part[((w0 + w) * 4 + 2 * gq + 1) * 64 + lane]; }
                    f32x4 g0, g1; unpack8(*(const u32x4*)(z + (size_t)row * DIN + ZC_GATE + 1024 * b3 + col), g0, g1);
#pragma unroll
                    for (int i = 0; i < 4; ++i) { m0[i] += sigmoidf_(g0[i]) * s0v[i]; m1[i] += sigmoidf_(g1[i]) * s1v[i]; } }
                *(u32x4*)(merged + (size_t)row * D + col) = pack8(m0, m1); }
        }
        __syncthreads();
    }
}

__device__ __forceinline__ void skinny_ple(LAS unsigned char* lds, const bf16_t* A  , const bf16_t* Bt  , const float* ssq, bf16_t* xout, float* ssq_out) {
    int tid_ = threadIdx.x; asm volatile("" : "+v"(tid_));
    const int wid = __builtin_amdgcn_readfirstlane(tid_ >> 6), lane = tid_ & 63, fr = lane & 15, fq = lane >> 4;
    const int s0 = wid < 4 ? 5 * wid : (wid < 7 ? 20 + 4 * (wid - 4) : 32), s1 = wid < 4 ? s0 + 5 : (wid < 7 ? s0 + 4 : 40);
    LAS f32x4* part = (LAS f32x4*)lds;
    const int G = NGRID;
    for (int u = (int)((blockIdx.x % 8u) * (NGRID / 8) + blockIdx.x / 8u); u < 8 * (D / 64); u += G) {
        const int rt = u & 7, cg = u >> 3, row0 = MP + 16 * rt, col0 = 64 * cg;
        const bf16_t* ap = A + (size_t)(row0 + fr) * XLD + 8 * fq;
        const bf16_t* bp[4];
#pragma unroll
        for (int n = 0; n < 4; ++n) bp[n] = Bt + (size_t)(col0 + 32 * (n >> 1) + 8 * (fr >> 2) + 4 * (n & 1) + (fr & 3)) * 1280 + 8 * fq;
        f32x4 acc[4];
#pragma unroll
        for (int n = 0; n < 4; ++n) acc[n] = (f32x4){0.f, 0.f, 0.f, 0.f};
#pragma unroll 8
        for (int st = s0; st < s1; ++st) { const bf16x8 a = *(const bf16x8*)(ap + 32 * st);
#pragma unroll
            for (int n = 0; n < 4; ++n) acc[n] = __builtin_amdgcn_mfma_f32_16x16x32_bf16(*(const bf16x8*)(bp[n] + 32 * st), a, acc[n], 0, 0, 0); }
#pragma unroll
        for (int n = 0; n < 4; ++n) part[(wid * 4 + n) * 64 + lane] = acc[n];
        __syncthreads();
        if (wid == 0) { const int row = row0 + fr; const float rs = row_rstd(ssq, row, fq); float sq = 0.f;
#pragma unroll
            for (int gq = 0; gq < 2; ++gq) { const int col = col0 + 32 * gq + 8 * fq;
                f32x4 g0 = part[(2 * gq) * 64 + lane], g1 = part[(2 * gq + 1) * 64 + lane];
#pragma unroll
                for (int w = 1; w < 7; ++w) { g0 += part[(w * 4 + 2 * gq) * 64 + lane]; g1 += part[(w * 4 + 2 * gq + 1) * 64 + lane]; }
                const f32x4 p0 = part[(7 * 4 + 2 * gq) * 64 + lane], p1 = part[(7 * 4 + 2 * gq + 1) * 64 + lane];
                f32x4 x0, x1; unpack8(*(const u32x4*)(A + (size_t)row * XLD + col), x0, x1);
#pragma unroll
                for (int i = 0; i < 4; ++i) { x0[i] += sigmoidf_(g0[i] * rs) * p0[i]; x1[i] += sigmoidf_(g1[i] * rs) * p1[i]; }
                *(u32x4*)(xout + (size_t)row * XLD + col) = pack8(x0, x1); sq += sumsq8(x0, x1); }
            sq += __shfl_xor(sq, 16); sq += __shfl_xor(sq, 32);
            if (fq == 0) ssq_out[(size_t)row * 16 + cg] = sq;
        }
        __syncthreads();
    }
}

struct AttnD { long rowbase; int dstride, qt0, qcol, kcol, vcol, ldo; bf16_t* obase; float* lsep; bool has_sink; float sink2; };
constexpr int ATT_V_OFF = 12 * 4608;
__device__ __forceinline__ AttnD attn_decode(int u, int hh, bf16_t* obr, bf16_t* odil, float* lse, const float* sinks) {
    AttnD d;
    if (u < 256) { const int blk = u & 15, kvh = (u >> 4) & 1, b = u >> 5, h = 4 * kvh + hh;
        d.rowbase = (long)b * SEQ; d.dstride = 1; d.qt0 = 8 * blk; d.qcol = ZC_QS + 64 * h; d.kcol = ZC_KS + 64 * kvh; d.vcol = ZC_VS + 64 * kvh;
        d.obase = obr + 512 + 64 * h; d.ldo = OBR_LD; d.lsep = nullptr; d.has_sink = true; d.sink2 = sinks[h] * LOG2E;
    } else { const int v = u - 256, gi = v >> 9, w = v & 511, blk16 = w & 15, h = (w >> 4) & 3, b = w >> 6, sh = 2 * gi, bps = 16 >> sh, r = blk16 / bps, blk = blk16 % bps, cb = ZC_DIL + 768 * gi;
        d.rowbase = (long)b * SEQ + r; d.dstride = 1 << sh; d.qt0 = 8 * blk; d.qcol = cb + 64 * h; d.kcol = cb + 256 + 64 * h; d.vcol = cb + 512 + 64 * h;
        d.obase = odil + (size_t)gi * MTP * 256 + 64 * h; d.ldo = 256; d.lsep = lse + (size_t)gi * MTP * 4 + h; d.has_sink = false; d.sink2 = 0.f; }
    return d;
}
__device__ __forceinline__ void attn_issue(const AttnD& d, const bf16_t* z, u32x4 (&pf)[12], bf16x8 (&qf)[4], int tid, int wave, int lane, int mode) {
    const int within = tid & 255, row = within >> 3, cc = within & 7, t0 = tid >> 8;
    if (mode == 2)
#pragma unroll
    for (int i = 0; i < 12; ++i) { const int tile = 2 * (i % 6) + t0; int kt = d.qt0 - 4 + tile; kt = kt < 0 ? 0 : kt;
        pf[i] = *(const u32x4*)(z + (size_t)(d.rowbase + (long)(32 * kt + row) * d.dstride) * DIN + (i < 6 ? d.kcol : d.vcol) + 8 * cc); }
    const int r32 = lane & 31, hi = lane >> 5;
    const bf16_t* zq = z + (size_t)(d.rowbase + (long)(32 * (d.qt0 + wave) + r32) * d.dstride) * DIN + d.qcol + 8 * hi;
#pragma unroll
    for (int s = 0; s < 4; ++s) qf[s] = *(const bf16x8*)(zq + 16 * s);
}
__device__ __forceinline__ void attn_stage(LAS unsigned char* lds, const u32x4 (&pf)[12], int tid) {
    const int within = tid & 255, row = within >> 3, cc = within & 7, t0 = tid >> 8;
#pragma unroll
    for (int i = 0; i < 12; ++i) { const int tile = 2 * (i % 6) + t0; *(LAS u32x4*)(lds + (i < 6 ? 0 : ATT_V_OFF) + tile * 4608 + row * 144 + cc * 16) = pf[i]; }
}
__device__ __forceinline__ void attn_wg_compute(const AttnD& d, const bf16x8 (&qf)[4], LAS unsigned char* lds, int wave, int lane, int mode, const AttnD& dn, const bf16_t* z, u32x4 (&pf)[12], bf16x8 (&qn)[4], int tid) {
    const int r32 = lane & 31, hi = lane >> 5, qt = d.qt0 + wave;
    const float NEG = -__builtin_inff();
    if (mode) attn_issue(dn, z, pf, qn, tid, wave, lane, mode);
    __builtin_amdgcn_sched_barrier(0);
    f32x16 S[5];
    const LAS unsigned char* kb = lds + wave * 4608 + r32 * 144 + 16 * hi;
#pragma unroll
    for (int j = 0; j < 5; ++j) { f32x16 acc;
#pragma unroll
        for (int r = 0; r < 16; ++r) acc[r] = 0.f;
#pragma unroll
        for (int s = 0; s < 4; ++s) acc = __builtin_amdgcn_mfma_f32_32x32x16_bf16(*(const LAS bf16x8*)(kb + j * 4608 + 32 * s), qf[s], acc, 0, 0, 0);
        S[j] = acc; }
    float m = NEG;
#pragma unroll
    for (int j = 0; j < 5; ++j) { const bool tv = (qt - 4 + j) >= 0;
#pragma unroll
        for (int r = 0; r < 16; ++r) { const int kk = (r & 3) + 8 * (r >> 2) + 4 * hi; float v = S[j][r];
            if (j == 0) v = (kk < r32) ? NEG : v;
            if (j == 4) v = (kk > r32) ? NEG : v;
            if (j < 4) v = tv ? v : NEG;
            S[j][r] = v; m = fmaxf(m, v); } }
    m = fmaxf(m, __shfl_xor(m, 32));
    float m2 = m * SCL2;
    if (d.has_sink) m2 = fmaxf(m2, d.sink2);
    u32x4 PW[5][2]; float l = 0.f;
#pragma unroll
    for (int j = 0; j < 5; ++j)
#pragma unroll
        for (int s2 = 0; s2 < 2; ++s2) { float p[8];
#pragma unroll
            for (int i = 0; i < 8; ++i) { p[i] = __builtin_amdgcn_exp2f(__builtin_fmaf(S[j][8 * s2 + i], SCL2, -m2)); l += p[i]; }
            PW[j][s2].x = pk2(p[0], p[1]); PW[j][s2].y = pk2(p[2], p[3]); PW[j][s2].z = pk2(p[4], p[5]); PW[j][s2].w = pk2(p[6], p[7]); }
    l += __shfl_xor(l, 32);
    if (d.has_sink) l += __builtin_amdgcn_exp2f(d.sink2 - m2);
    const float inv = __builtin_amdgcn_rcpf(l);
    f32x16 O0, O1;
#pragma unroll
    for (int r = 0; r < 16; ++r) { O0[r] = 0.f; O1[r] = 0.f; }
    const int q4 = (lane & 15) >> 2, p4 = lane & 3, blk = (lane >> 4) & 1;
    const LAS unsigned char* trb = lds + ATT_V_OFF + wave * 4608 + (4 * hi + q4) * 144 + (16 * blk + 4 * p4) * 2;
#pragma unroll
    for (int j = 0; j < 5; ++j) {
#pragma unroll
        for (int s2 = 0; s2 < 2; ++s2) {
            const bf16x8 pa = __builtin_bit_cast(bf16x8, PW[j][s2]);
#pragma unroll
            for (int dh = 0; dh < 2; ++dh) {
                const s16x4 lo = __builtin_bit_cast(s16x4, __builtin_amdgcn_ds_read_tr16_b64_v4i16((LAS s16x4*)(trb + j * 4608 + (16 * s2) * 144 + 64 * dh)));
                const s16x4 hh = __builtin_bit_cast(s16x4, __builtin_amdgcn_ds_read_tr16_b64_v4i16((LAS s16x4*)(trb + j * 4608 + (16 * s2 + 8) * 144 + 64 * dh)));
                const bf16x8 vb = __builtin_shufflevector(lo, hh, 0, 1, 2, 3, 4, 5, 6, 7);
                if (dh == 0) O0 = __builtin_amdgcn_mfma_f32_32x32x16_bf16(vb, pa, O0, 0, 0, 0);
                else         O1 = __builtin_amdgcn_mfma_f32_32x32x16_bf16(vb, pa, O1, 0, 0, 0);
            }
        }
    }
    u32x2 o2[8];
#pragma unroll
    for (int g4 = 0; g4 < 4; ++g4) {
        o2[g4].x = pk2(O0[4 * g4] * inv, O0[4 * g4 + 1] * inv); o2[g4].y = pk2(O0[4 * g4 + 2] * inv, O0[4 * g4 + 3] * inv);
        o2[4 + g4].x = pk2(O1[4 * g4] * inv, O1[4 * g4 + 1] * inv); o2[4 + g4].y = pk2(O1[4 * g4 + 2] * inv, O1[4 * g4 + 3] * inv); }
    unsigned char* orow = (unsigned char*)(d.obase + (size_t)(d.rowbase + (long)(32 * qt + r32) * d.dstride) * d.ldo) + 16 * hi;
#pragma unroll
    for (int k = 0; k < 8; k += 2) {
        const auto rx = __builtin_amdgcn_permlane32_swap(o2[k].x, o2[k + 1].x, false, false);
        const auto ry = __builtin_amdgcn_permlane32_swap(o2[k].y, o2[k + 1].y, false, false);
        u32x4 w; w.x = rx[0]; w.y = ry[0]; w.z = rx[1]; w.w = ry[1];
        *(u32x4*)(orow + 16 * k) = w; }
    if (d.lsep && hi == 0) d.lsep[(size_t)(d.rowbase + (long)(32 * qt + r32) * d.dstride) * 4] = (m2 + __builtin_amdgcn_logf(l)) * LN2;
}

__device__ __forceinline__ void attn_phase_wg(const bf16_t* z, bf16_t* obr, bf16_t* odil, float* lse, const float* sinks, LAS unsigned char* lds, int bx, int G) {
    int tid_ = threadIdx.x; asm volatile("" : "+v"(tid_));
    const int tid = tid_, lane = tid & 63, wave = __builtin_amdgcn_readfirstlane(tid >> 6);
    u32x4 pf[12]; bf16x8 qf[4], qn[4];
    constexpr int NU = 256 + 1536;
    int u = (G % 8 == 0) ? (bx % 8) * 32 + (bx / 8) % 32 + (bx / 256) * 256 : bx;
    if (u < NU) { const AttnD d0 = attn_decode(u, 0, obr, odil, lse, sinks); attn_issue(d0, z, pf, qn, tid, wave, lane, 2); }
    for (; u < NU; u += G) {
        asm volatile("s_waitcnt lgkmcnt(0)\n\ts_barrier" ::: "memory");
        attn_stage(lds, pf, tid);
        asm volatile("s_waitcnt lgkmcnt(0)\n\ts_barrier" ::: "memory");
        const int nh = (u < 256) ? 4 : 1; const bool has_next = u + G < NU;
        for (int hh = 0; hh < nh; ++hh) {
            const AttnD d = attn_decode(u, hh, obr, odil, lse, sinks);
#pragma unroll
            for (int s = 0; s < 4; ++s) qf[s] = qn[s];
            const bool lasth = hh + 1 == nh; const int mode = lasth ? (has_next ? 2 : 0) : 1;
            const AttnD dn = lasth ? attn_decode(has_next ? u + G : u, 0, obr, odil, lse, sinks) : attn_decode(u, hh + 1, obr, odil, lse, sinks);
            attn_wg_compute(d, qf, lds, wave, lane, mode, dn, z, pf, qn, tid);
        }
    }
    __syncthreads();
}

__device__ __forceinline__ void sample_attn_core(const bf16_t* zrow  , int qcol, int kcol, int vcol, const float* cache  , int rowf  ,
                                                 int vofs  , int dil, bool has_sink, float sink2, LAS unsigned char* wl, int lane, f32x4& o_out, float& lse_out) {
    const int sub = lane & 15, kg = lane >> 4;
    const float NEG = -__builtin_inff();
    f32x4 q; { const u32x2 w = *(const u32x2*)(zrow + qcol + 4 * sub); q = (f32x4){bflo(w.x), bfhi(w.x), bflo(w.y), bfhi(w.y)}; }
    f32x4 kn; { const u32x2 w = *(const u32x2*)(zrow + kcol + 4 * sub); kn = (f32x4){bflo(w.x), bfhi(w.x), bflo(w.y), bfhi(w.y)}; }
    f32x4 vn; { const u32x2 w = *(const u32x2*)(zrow + vcol + 4 * sub); vn = (f32x4){bflo(w.x), bfhi(w.x), bflo(w.y), bfhi(w.y)}; }
    LAS float* scl = (LAS float*)wl;
    float m = NEG;
#pragma unroll 16
    for (int st = 0; st < 32; ++st) { const int key = 4 * st + kg;
        const f32x4 k4 = *(const f32x4*)(cache + (size_t)key * dil * rowf + 4 * sub);
        float d = (q[0] * k4[0] + q[1] * k4[1]) + (q[2] * k4[2] + q[3] * k4[3]);
        d += __shfl_xor(d, 1); d += __shfl_xor(d, 2); d += __shfl_xor(d, 4); d += __shfl_xor(d, 8);
        d *= SCL2; m = fmaxf(m, d);
        if (sub == 0) scl[st * 4 + kg] = d; }
    float sn = (q[0] * kn[0] + q[1] * kn[1]) + (q[2] * kn[2] + q[3] * kn[3]);
    sn += __shfl_xor(sn, 1); sn += __shfl_xor(sn, 2); sn += __shfl_xor(sn, 4); sn += __shfl_xor(sn, 8);
    sn *= SCL2;
    m = fmaxf(m, sn);
    m = fmaxf(m, __shfl_xor(m, 16)); m = fmaxf(m, __shfl_xor(m, 32));
    if (has_sink) m = fmaxf(m, sink2);
    float l = 0.f; f32x4 o = {0.f, 0.f, 0.f, 0.f};
#pragma unroll 16
    for (int st = 0; st < 32; ++st) { const int key = 4 * st + kg; const float p = __builtin_amdgcn_exp2f(scl[st * 4 + kg] - m); l += p;
        const f32x4 v4 = *(const f32x4*)(cache + (size_t)key * dil * rowf + vofs + 4 * sub); o += v4 * p; }
    l += __shfl_xor(l, 16); l += __shfl_xor(l, 32);
#pragma unroll
    for (int i = 0; i < 4; ++i) { o[i] += __shfl_xor(o[i], 16); o[i] += __shfl_xor(o[i], 32); }
    const float pn = __builtin_amdgcn_exp2f(sn - m); l += pn; o += vn * pn;
    if (has_sink) l += __builtin_amdgcn_exp2f(sink2 - m);
    const float inv = 1.f / l;
    o_out = o * inv; lse_out = (m + __builtin_amdgcn_logf(l)) * LN2;
}

__device__ __forceinline__ void sample_dil_unit(const bf16_t* zrow, int cb, const float* cache  , int dil, bf16_t* orow  , float* lserow  , LAS unsigned char* wl, int lane) {
    const int sub = lane & 15, head = lane >> 4, co = 64 * head + 4 * sub;
    f32x4 q; { const u32x2 w = *(const u32x2*)(zrow + cb + co); q = (f32x4){bflo(w.x), bfhi(w.x), bflo(w.y), bfhi(w.y)}; }
    f32x4 kn; { const u32x2 w = *(const u32x2*)(zrow + cb + 256 + co); kn = (f32x4){bflo(w.x), bfhi(w.x), bflo(w.y), bfhi(w.y)}; }
    f32x4 vn; { const u32x2 w = *(const u32x2*)(zrow + cb + 512 + co); vn = (f32x4){bflo(w.x), bfhi(w.x), bflo(w.y), bfhi(w.y)}; }
    LAS float* scl = (LAS float*)wl;
    const float* kp = cache + co; const size_t rs = (size_t)dil * 512;
    float m = -__builtin_inff();
#pragma unroll 1
    for (int s0 = 0; s0 < 128; s0 += 32) { f32x4 kb[32];
#pragma unroll
        for (int i = 0; i < 32; ++i) kb[i] = __builtin_nontemporal_load((const f32x4*)(kp + (size_t)(s0 + i) * rs));
#pragma unroll
        for (int i = 0; i < 32; ++i) { float d = (q[0] * kb[i][0] + q[1] * kb[i][1]) + (q[2] * kb[i][2] + q[3] * kb[i][3]);
            d += __shfl_xor(d, 1); d += __shfl_xor(d, 2); d += __shfl_xor(d, 4); d += __shfl_xor(d, 8);
            d *= SCL2; m = fmaxf(m, d); if (sub == 0) scl[(s0 + i) * 4 + head] = d; } }
    float sn = (q[0] * kn[0] + q[1] * kn[1]) + (q[2] * kn[2] + q[3] * kn[3]);
    sn += __shfl_xor(sn, 1); sn += __shfl_xor(sn, 2); sn += __shfl_xor(sn, 4); sn += __shfl_xor(sn, 8);
    sn *= SCL2; m = fmaxf(m, sn);
    float l = 0.f; f32x4 o = {0.f, 0.f, 0.f, 0.f};
#pragma unroll 1
    for (int s0 = 0; s0 < 128; s0 += 32) { f32x4 vb[32];
#pragma unroll
        for (int i = 0; i < 32; ++i) vb[i] = __builtin_nontemporal_load((const f32x4*)(kp + 256 + (size_t)(s0 + i) * rs));
#pragma unroll
        for (int i = 0; i < 32; ++i) { const float p = __builtin_amdgcn_exp2f(scl[(s0 + i) * 4 + head] - m); l += p; o += vb[i] * p; } }
    const float pn = __builtin_amdgcn_exp2f(sn - m); l += pn; o += vn * pn;
    const float inv = __builtin_amdgcn_rcpf(l);
    { u32x2 w; w.x = pk2(o[0] * inv, o[1] * inv); w.y = pk2(o[2] * inv, o[3] * inv); *(u32x2*)(orow + co) = w; }
    if (sub == 0) lserow[head] = (m + __builtin_amdgcn_logf(l)) * LN2;
}

#define XB_TMO      128
#define XB_XCNT(j)  (256  + 64 * (j))
#define XB_XSUB(j)  (1280 + 64 * (j))
#define XB_XGEN(j)  (2304 + 64 * (j))
#define XB_TOP      3328
#define XB_TOPGEN   3392
#define XCD_BAR_WORDS 3456
#define XB_SPIN_CAP (1u << 18)
__device__ __forceinline__ unsigned xb_ld(unsigned* p)              { return __hip_atomic_load(p, __ATOMIC_RELAXED, __HIP_MEMORY_SCOPE_AGENT); }
__device__ __forceinline__ unsigned xb_add(unsigned* p, unsigned v) { return __hip_atomic_fetch_add(p, v, __ATOMIC_RELAXED, __HIP_MEMORY_SCOPE_AGENT); }
__device__ __forceinline__ unsigned xb_xcc_id() { return (unsigned)__builtin_amdgcn_s_getreg((3 << 11) | 20) & 0xFu; }
#define XB_SPIN(cond, bar) do { unsigned _sp = 0; while (cond) { __builtin_amdgcn_s_sleep(1); \
    if ((++_sp & 255u) == 0u) { if (xb_ld(&(bar)[XB_TMO])) break; if (_sp > XB_SPIN_CAP) { atomicAdd(&(bar)[XB_TMO], 1u); break; } } } } while (0)
struct XcdBarrier { unsigned* bar; unsigned x; volatile LAS unsigned* st; };
__device__ __forceinline__ XcdBarrier xcd_barrier_post(unsigned* bar, volatile LAS unsigned* st) {
    XcdBarrier b; b.bar = bar; b.x = xb_xcc_id(); b.st = st;
    if (threadIdx.x == 0) (void)xb_add(&bar[XB_XCNT(b.x)], 1u);
    return b;
}
__device__ __forceinline__ void xcd_barrier_complete(unsigned* bar, unsigned x, unsigned& nloc, unsigned& nx) {
    const unsigned G = gridDim.x * gridDim.y * gridDim.z;
    unsigned sum, cnt, mine, sp = 0u;
    for (;;) {
        sum = 0u; cnt = 0u; mine = 0u;
#pragma unroll
        for (unsigned j = 0; j < 16; ++j) { const unsigned c = xb_ld(&bar[XB_XCNT(j)]); sum += c; cnt += (c > 0u) ? 1u : 0u; mine = (j == x) ? c : mine; }
        if (sum == G) break;
        __builtin_amdgcn_s_sleep(1);
        if ((++sp & 255u) == 0u) { if (xb_ld(&bar[XB_TMO])) break; if (sp > XB_SPIN_CAP) { atomicAdd(&bar[XB_TMO], 1u); break; } }
    }
    nloc = mine > 0u ? mine : 1u; nx = cnt > 0u ? cnt : 1u;
}
__device__ __forceinline__ void xcd_barrier(const XcdBarrier& b) {
    asm volatile("s_waitcnt vmcnt(0)" ::: "memory");
    __syncthreads();
    if (threadIdx.x == 0) {
        unsigned* bar = b.bar;
        __builtin_amdgcn_s_waitcnt(0);
        unsigned nloc = b.st[0], nx = b.st[1];
        if (nloc == 0u) { xcd_barrier_complete(bar, b.x, nloc, nx); b.st[0] = nloc; b.st[1] = nx; }
        const unsigned old = xb_add(&bar[XB_XSUB(b.x)], 1u);
        const unsigned gen = old / nloc;
        if (old + 1u == (gen + 1u) * nloc) {
            __builtin_amdgcn_fence(__ATOMIC_RELEASE, "agent");
            asm volatile("s_waitcnt vmcnt(0)" ::: "memory");
            const unsigned og = xb_add(&bar[XB_TOP], 1u);
            const unsigned tg = og / nx;
            if (og + 1u == (tg + 1u) * nx) xb_add(&bar[XB_TOPGEN], 1u);
            else XB_SPIN(xb_ld(&bar[XB_TOPGEN]) == tg, bar);
            __builtin_amdgcn_fence(__ATOMIC_ACQUIRE, "agent");
            xb_add(&bar[XB_XGEN(b.x)], 1u);
            asm volatile("s_waitcnt vmcnt(0)" ::: "memory");
        } else {
            XB_SPIN(xb_ld(&bar[XB_XGEN(b.x)]) == gen, bar);
            __builtin_amdgcn_fence(__ATOMIC_ACQUIRE, "agent");
            asm volatile("s_waitcnt vmcnt(0)" ::: "memory");
        }
    }
    __syncthreads();
}

constexpr int RING_BYTES = 131072, LDS_BYTES = 163840, MISC_OFF = LDS_BYTES - 512;
constexpr int C_ES = 0, C_ES_LD = 272, C_T = 256 * C_ES_LD  , C_WS = C_T + 77824  , C_WS_SZ = 2048;
static_assert(C_WS + 7 * C_WS_SZ <= MISC_OFF, "phase C LDS map");
constexpr int NWAVES = 8, NTHREADS = 512;

constexpr int RSTD_OFF = RING_BYTES;
template <class Sched>
__device__ __forceinline__ void fill_rstd(LAS unsigned char* lds, const float* ssq, const Sched& S) {
    int tid_o = threadIdx.x; asm volatile("" : "+v"(tid_o));
    LAS float* rt = (LAS float*)(lds + RSTD_OFF);
    const int r = tid_o >> 1, hf = tid_o & 1;
    for (int i = 0; ; i += 4) {
        pg8::Unit u[4]; bool ok[4];
#pragma unroll
        for (int k = 0; k < 4; ++k) ok[k] = S.next(i + k, u[k]);
        if (!ok[0]) break;
        f32x4 a[4], b[4];
#pragma unroll
        for (int k = 0; k < 4; ++k) if (ok[k]) { const float* p = ssq + (size_t)(u[k].pm * 256 + r) * 16 + 8 * hf; a[k] = *(const f32x4*)p; b[k] = *(const f32x4*)(p + 4); }
#pragma unroll
        for (int k = 0; k < 4; ++k) if (ok[k]) { float sacc = ((a[k][0] + a[k][1]) + (a[k][2] + a[k][3])) + ((b[k][0] + b[k][1]) + (b[k][2] + b[k][3]));
            sacc += __shfl_xor(sacc, 1);
            if (hf == 0) rt[(i + k) * 256 + r] = rsqrtf(sacc * (1.f / D) + EPS); }
    }
    __syncthreads();
}

__device__ __forceinline__ void p0_transpose_item(const float* W, int K, int N, bf16_t* WT, int ldw, const float* gain, LAS unsigned char* scr, int item, int lane) {
    const int nblk = N / 64, kb = item / nblk, nb = item % nblk, k0 = 64 * kb, n0 = 64 * nb;
    const float* src = W + (size_t)k0 * N + n0 + lane;
    float v[64];
#pragma unroll
    for (int k = 0; k < 64; ++k) v[k] = __builtin_nontemporal_load(src + (size_t)k * N);
    if (gain) {
#pragma unroll
        for (int k = 0; k < 64; ++k) v[k] *= gain[k0 + k];
    }
#pragma unroll
    for (int c = 0; c < 8; ++c) { u32x4 o; o.x = pk2(v[8 * c], v[8 * c + 1]); o.y = pk2(v[8 * c + 2], v[8 * c + 3]); o.z = pk2(v[8 * c + 4], v[8 * c + 5]); o.w = pk2(v[8 * c + 6], v[8 * c + 7]);
        *(LAS u32x4*)(scr + lane * 144 + c * 16) = o; }
    LDS_WAIT(); asm volatile("" ::: "memory");
    bf16_t* dst = WT + (size_t)n0 * ldw + k0 + 8 * (lane & 7);
#pragma unroll
    for (int j = 0; j < 8; ++j) { const int r = 8 * j + (lane >> 3); const u32x4 o = *(const LAS u32x4*)(scr + r * 144 + (lane & 7) * 16); *(u32x4*)(dst + (size_t)r * ldw) = o; }
    LDS_WAIT(); asm volatile("" ::: "memory");
}

struct Args { const float* in[33]; float* out; unsigned char* ws; int ph_lo, ph_hi; };
constexpr int NPHASE = 22;

__global__ void __launch_bounds__(NTHREADS, 2) fwd_kernel(Args args) {
    extern __shared__ __attribute__((aligned(16))) unsigned char lds_raw[];
    LAS unsigned char* lds = (LAS unsigned char*)lds_raw;
    const int tid = threadIdx.x, lane = tid & 63, wave = __builtin_amdgcn_readfirstlane(tid >> 6);
    constexpr int G = NGRID;
    if (gridDim.x != (unsigned)NGRID) return;
    const int bx = blockIdx.x; const int vcu = (G % 8 == 0) ? (bx % 8) * (G / 8) + bx / 8 : bx;
    const int gw = vcu * NWAVES + wave, NGW = G * NWAVES;
    const int NGT = G * NTHREADS;
    unsigned char* ws = args.ws;
    unsigned* ctl = (unsigned*)(ws + WS_CTL);
    volatile LAS unsigned* MISC = (volatile LAS unsigned*)(lds + MISC_OFF);
    for (int u = tid; u < (LDS_BYTES - RING_BYTES) / 4; u += NTHREADS) ((LAS unsigned*)(lds + RING_BYTES))[u] = 0u;
    __syncthreads();
#if MK_ONE_LAUNCH
    XcdBarrier bar = xcd_barrier_post(ctl + 1024, MISC + 8);
#define GRID_BAR() xcd_barrier(bar)
#else
#define GRID_BAR() do { } while (0)
#endif
    const int lo = args.ph_lo, hi = args.ph_hi;
#ifndef PHM
#define PHM 0xFFFFFFFFu
#endif
#define IN(k) (lo <= (k) && (k) < hi)
#define INL(j) (((PHM >> (1 + (j))) & 1u) && IN(pbase + (j)))
#ifndef REPM
#define REPM 0u
#endif
#define NREP(k) (((REPM >> (k)) & 1u) ? 2 : 1)
#ifndef REPB
#define REPB 0u
#endif
#define NREPB(b) ((REPB & (b)) ? 2 : 1)
#ifndef REPP
#define REPP 0u
#endif
#define NREPP(b) ((REPP & (b)) ? 2 : 1)
#ifndef REPC
#define REPC 0u
#endif
#define NREPC(b) ((REPC & (b)) ? 2 : 1)
#define SEAM(k) do { if (IN(k) && IN((k) + 1)) GRID_BAR(); } while (0)

    bf16_t* xbdum = (bf16_t*)(ws + WS_XBDUM); float* ssqdum = (float*)(ws + WS_SSQDUM); (void)xbdum; (void)ssqdum;
    bf16_t* z = (bf16_t*)(ws + WS_Z);
    bf16_t* obr = (bf16_t*)(ws + WS_OBR);
    bf16_t* odil = (bf16_t*)(ws + WS_ODIL);
    float* lse = (float*)(ws + WS_LSE);
    float* Ebuf = (float*)(ws + WS_E);
    bf16_t* Sin = (bf16_t*)(ws + WS_SIN);
    bf16_t* gact = (bf16_t*)(ws + WS_GACT);
    bf16_t* merged = (bf16_t*)(ws + WS_MERGED);
    bf16_t* hid = (bf16_t*)(ws + WS_HID);
    bf16_t* ppb = (bf16_t*)(ws + WS_PP);

    if ((PHM & 1u) && IN(0)) for (int rep = 0; rep < NREP(0); ++rep) {
        int tid_o = threadIdx.x; asm volatile("" : "+v"(tid_o)); const int tid = tid_o, lane = tid_o & 63, gth = vcu * NTHREADS + tid_o;
        const int GA = (G > 128) ? G - 64 : G;
        LAS unsigned char* scr = lds + wave * 16384;
        constexpr int I_IN = (D / 64) * (DIN / 64), I_GLU = 8 * 8, I_BA = 8 * 16, I_BC = 4 * 16, I_OUT = 16 * 16, I_UP = 16 * 64, I_DOWN = 64 * 16, I_PP = 4 * 16;
        constexpr int I_L = I_IN + I_GLU + 2 * I_BA + I_BC + I_OUT + I_UP + I_DOWN + I_OUT + I_PP;
        for (int rp = 0; rp < NREPP(1u); ++rp)
        if (bx < GA)
        for (int it = bx * NWAVES + wave; it < NLAYER * I_L; it += GA * NWAVES) {
            const int l = it / I_L; int r = it % I_L;
            bf16_t* wl_ = (bf16_t*)(ws + WS_W + (size_t)l * WL_BYTES);
            if (r < I_IN) { p0_transpose_item(args.in[9] + (size_t)l * D * DIN, D, DIN, wl_ + WO_IN, D, args.in[10] + l * D, scr, r, lane); continue; } r -= I_IN;
            if (r < I_GLU) { p0_transpose_item(args.in[19] + (size_t)l * 512 * 512, 512, 512, wl_ + WO_GLU, 512, nullptr, scr, r, lane); continue; } r -= I_GLU;
            if (r < I_BA) { p0_transpose_item(args.in[22] + (size_t)l * 512 * D, 512, D, wl_ + WO_BR, 1280, nullptr, scr, r, lane); continue; } r -= I_BA;
            if (r < I_BA) { p0_transpose_item(args.in[23] + (size_t)l * 512 * D, 512, D, wl_ + WO_BR + 512, 1280, nullptr, scr, r, lane); continue; } r -= I_BA;
            if (r < I_BC) { p0_transpose_item(args.in[24] + (size_t)l * 256 * D, 256, D, wl_ + WO_BR + 1024, 1280, nullptr, scr, r, lane); continue; } r -= I_BC;
            if (r < I_OUT) { p0_transpose_item(args.in[25] + (size_t)l * D * D, D, D, wl_ + WO_OUT, D, nullptr, scr, r, lane); continue; } r -= I_OUT;
            if (r < I_UP) { p0_transpose_item(args.in[27] + (size_t)l * D * DFF, D, DFF, wl_ + WO_UP, D, args.in[26] + l * D, scr, r, lane); continue; } r -= I_UP;
            if (r < I_DOWN) { p0_transpose_item(args.in[28] + (size_t)l * DFF * D, DFF, D, wl_ + WO_DOWN, DFF, nullptr, scr, r, lane); continue; } r -= I_DOWN;
            if (r < I_OUT) { p0_transpose_item(args.in[30] + (size_t)l * D * D, D, D, wl_ + WO_PGP, 1280, args.in[29] + l * D, scr, r, lane); continue; } r -= I_OUT;
            p0_transpose_item(args.in[31] + (size_t)l * PLE * D, PLE, D, wl_ + WO_PGP + 1024, 1280, nullptr, scr, r, lane);
        }
        { bf16_t* xb0 = (bf16_t*)(ws + WS_XB0); float* ssq0 = (float*)(ws + WS_SSQ0);
          for (int rp = 0; rp < NREPP(2u); ++rp)
          for (int m0 = 4 * gw; m0 < MT; m0 += 4 * NGW) {
            f32x4 v[4][4];
#pragma unroll
            for (int rr = 0; rr < 4; ++rr) { const int m = m0 + rr; const float* src = (m < MP) ? args.in[0] + (size_t)m * D : args.in[1] + (size_t)(m - MP) * D;
#pragma unroll
                for (int j = 0; j < 4; ++j) v[rr][j] = __builtin_nontemporal_load((const f32x4*)(src + 4 * lane + 256 * j)); }
#pragma unroll
            for (int rr = 0; rr < 4; ++rr) { const int m = m0 + rr; float sq = 0.f;
#pragma unroll
                for (int j = 0; j < 4; ++j) { sq += (v[rr][j][0] * v[rr][j][0] + v[rr][j][1] * v[rr][j][1]) + (v[rr][j][2] * v[rr][j][2] + v[rr][j][3] * v[rr][j][3]);
                    u32x2 w; w.x = pk2(v[rr][j][0], v[rr][j][1]); w.y = pk2(v[rr][j][2], v[rr][j][3]); *(u32x2*)(xb0 + (size_t)m * XLD + 4 * lane + 256 * j) = w; }
                sq = wave_sum(sq);
                if (lane < 16) ssq0[(size_t)m * 16 + lane] = (lane == 0) ? sq : 0.f; }
          } }
        for (int rp = 0; rp < NREPP(4u); ++rp)
#pragma unroll 4
        for (int it = gth; it < NLAYER * MT * 32; it += NGT) {
            const int l = it / (MT * 32), r = it % (MT * 32), m = r >> 5, c8 = r & 31;
            const float* src = (m < MP) ? args.in[7] + ((size_t)l * MP + m) * PLE + 8 * c8 : args.in[8] + ((size_t)l * MS + (m - MP)) * PLE + 8 * c8;
            const f32x4 a = __builtin_nontemporal_load((const f32x4*)src), b = __builtin_nontemporal_load((const f32x4*)(src + 4));
            *(u32x4*)((bf16_t*)(ws + (l ? WS_XB1 : WS_XB0)) + (size_t)m * XLD + 1024 + 8 * c8) = pack8(a, b);
        }
        for (int rp = 0; rp < NREPP(8u); ++rp)
        for (int it = (G > 128) ? bx - (G - 64) : bx; it >= 0 && it < NLAYER * 32; it += (G > 128) ? 64 : G) {
            const int l = it >> 5, g = it & 31;
            LAS float* lamp = (LAS float*)lds;
            LAS float* bbs = lamp + 17 * 64 * 2;
            LAS float* cs = bbs + 64 * 16 * 2;
            unsigned char* sl = ws + WS_SSM + (size_t)l * SL_BYTES;
            __syncthreads();
            { const int p = tid & 63, kg = tid >> 6;
                const double dt = exp((double)args.in[13][l * 32 + g]);
                const double are = args.in[11][(l * 32 + g) * 64 + p], aim = args.in[12][(l * 32 + g) * 64 + p];
                for (int k = kg; k <= 16; k += 8) { const double mag = exp(k * are * dt), ang = k * aim * dt; const float cr = (float)(mag * cos(ang)), ci = (float)(mag * sin(ang));
                    lamp[(k * 64 + p) * 2] = cr; lamp[(k * 64 + p) * 2 + 1] = ci;
                    if (k == 16) { float* LAM16 = (float*)(sl + SO_LAM16) + (g * 64 + p) * 2; LAM16[0] = cr; LAM16[1] = ci; } }
                if (kg == 1) {
                    const double mag = exp(are * dt), lr = mag * cos(aim * dt), li = mag * sin(aim * dt), den = are * are + aim * aim;
                    const double zr = ((lr - 1.0) * are + li * aim) / den, zi = (li * are - (lr - 1.0) * aim) / den;
                    float* LAM = (float*)(sl + SO_LAM) + (g * 64 + p) * 2; float* BBo = (float*)(sl + SO_BB) + (size_t)(g * 64 + p) * 32;
                    LAM[0] = (float)lr; LAM[1] = (float)li;
                    for (int h = 0; h < 16; ++h) { const double br = args.in[14][((size_t)(l * 32 + g) * 64 + p) * 16 + h], bi = args.in[15][((size_t)(l * 32 + g) * 64 + p) * 16 + h];
                        const float xr = (float)(zr * br - zi * bi), xi = (float)(zr * bi + zi * br);
                        bbs[(p * 16 + h) * 2] = xr; bbs[(p * 16 + h) * 2 + 1] = xi; BBo[h * 2] = xr; BBo[h * 2 + 1] = xi; }
                }
            }
            for (int e = tid; e < 1024; e += NTHREADS) { cs[e * 2] = args.in[16][(size_t)(l * 32 + g) * 1024 + e]; cs[e * 2 + 1] = args.in[17][(size_t)(l * 32 + g) * 1024 + e]; }
            __syncthreads();
            bf16_t* KT = (bf16_t*)(sl + SO_KT) + (size_t)g * 4096; bf16_t* GT = (bf16_t*)(sl + SO_GT) + (size_t)g * 32768; bf16_t* Ft = (bf16_t*)(sl + SO_F) + (size_t)g * 32768;
            for (int e = tid; e < 4096; e += NTHREADS) { const int lag = e >> 8, hp = (e >> 4) & 15, h = e & 15; float s = 0.f;
                for (int p = 0; p < 64; ++p) { const float lr = lamp[(lag * 64 + p) * 2], li = lamp[(lag * 64 + p) * 2 + 1], br = bbs[(p * 16 + h) * 2], bi = bbs[(p * 16 + h) * 2 + 1];
                    const float wr_ = lr * br - li * bi, wi_ = lr * bi + li * br; s += cs[(hp * 64 + p) * 2] * wr_ - cs[(hp * 64 + p) * 2 + 1] * wi_; }
                if (lag == 0 && hp == h) s += args.in[18][l * 512 + g * 16 + h];
                KT[e] = f2bf(s); }
            for (int e = tid; e < 32768; e += NTHREADS) { const int t = e >> 11, hp = (e >> 7) & 15, ri = e & 1, p = (e >> 1) & 63;
                const float lr = lamp[((t + 1) * 64 + p) * 2], li = lamp[((t + 1) * 64 + p) * 2 + 1], cr = cs[(hp * 64 + p) * 2], ci = cs[(hp * 64 + p) * 2 + 1];
                GT[e] = f2bf(ri == 0 ? (cr * lr - ci * li) : -(cr * li + ci * lr)); }
            for (int e = tid; e < 32768; e += NTHREADS) { const int ri = (e >> 8) & 1, p = e >> 9, j = (e >> 4) & 15, h = e & 15;
                const float lr = lamp[((15 - j) * 64 + p) * 2], li = lamp[((15 - j) * 64 + p) * 2 + 1], br = bbs[(p * 16 + h) * 2], bi = bbs[(p * 16 + h) * 2 + 1];
                Ft[e] = f2bf(ri == 0 ? (lr * br - li * bi) : (lr * bi + li * br)); }
        }
        __syncthreads();
    }
    SEAM(0);

    for (int l = 0; l < NLAYER; ++l) {
        const int pbase = 1 + 10 * l;
        bf16_t* wl_ = (bf16_t*)(ws + WS_W + (size_t)l * WL_BYTES);
        unsigned char* sl = ws + WS_SSM + (size_t)l * SL_BYTES;
        bf16_t* xb_cur = (bf16_t*)(ws + ((l & 1) ? WS_XB1 : WS_XB0)); bf16_t* xb_nxt = (bf16_t*)(ws + ((l & 1) ? WS_XB0 : WS_XB1));
        float* ssq_cur = (float*)(ws + ((l & 1) ? WS_SSQ1 : WS_SSQ0)); float* ssq_nxt = (float*)(ws + ((l & 1) ? WS_SSQ0 : WS_SSQ1));

        if (INL(0)) for (int rep = 0; rep < NREP(1); ++rep) { const bool dry = rep + 1 < NREP(1); (void)dry;
            const FWin f{ssq_cur, z, (const LAS float*)(lds + RSTD_OFF)};
            { pg8::Gemm g{xb_cur, wl_ + WO_IN, MP, DIN, D, XLD, D}; pg8::StaticOrder S; S.init(MP, DIN, G, bx); fill_rstd(lds, ssq_cur, S); const EpiP<FWin> E{f};
              pg8::gemm_phase<EpiP<FWin>, pg8::StaticOrder, true, true>(lds, g, S, E); }
            skinny_gemm<false>(lds, xb_cur, XLD, wl_ + WO_IN, D, DIN, D, f, nullptr, true);
        }
        SEAM(pbase + 0);

        if (INL(1)) for (int rep = 0; rep < NREP(2); ++rep) { const bool dry = rep + 1 < NREP(2); (void)dry;
            int tid_o = threadIdx.x; asm volatile("" : "+v"(tid_o)); const int lane = tid_o & 63; const int tid = tid_o;
            LAS unsigned char* wlds = lds + wave * 4608;
            const float* sinks = args.in[21] + l * 8;
            for (int rb = 0; rb < NREPB(1u); ++rb) attn_phase_wg(z, obr, odil, lse, sinks, lds, bx, G);
        }

        if (INL(2)) for (int rep = 0; rep < NREP(3); ++rep) { const bool dry = rep + 1 < NREP(3); (void)dry;
            int tid_o = threadIdx.x; asm volatile("" : "+v"(tid_o)); const int lane = tid_o & 63;
            const int g_own = vcu & 31, b_own = vcu >> 5;
            {
              const int tid = wave * 64 + lane, fr = lane & 15, fq = lane >> 4; const bf16_t* Fall = (const bf16_t*)(sl + SO_F);
              bf16x8 ubq[2][8];
#pragma unroll
              for (int uu = 0; uu < 2; ++uu) { const int n = (b_own * 16 + wave * 2 + uu) * 16 + fr; const bf16_t* zu = z + (size_t)(16 * n + (fq >> 1)) * DIN + 16 * g_own + 8 * (fq & 1);
#pragma unroll
                  for (int s = 0; s < 8; ++s) ubq[uu][s] = *(const bf16x8*)(zu + (size_t)(2 * s) * DIN); }
              for (int i = tid; i < 4096; i += NTHREADS) { const int row = i >> 5, c = i & 31; *(LAS u32x4*)(lds + C_T + row * 528 + c * 16) = *(const u32x4*)(Fall + (size_t)g_own * 32768 + row * 256 + c * 8); }
              __syncthreads();
#pragma unroll
              for (int uu = 0; uu < 2; ++uu) { const int ntl = wave * 2 + uu, cl = ntl * 16 + fr;
                  bf16x8 ub[8];
#pragma unroll
                  for (int s = 0; s < 8; ++s) ub[s] = ubq[uu][s];
                  const LAS unsigned char* Fl = lds + C_T + fr * 528 + 16 * fq;
#pragma unroll
                  for (int mt = 0; mt < 8; ++mt) { f32x4 acc = {0.f, 0.f, 0.f, 0.f};
#pragma unroll
                      for (int s = 0; s < 8; ++s) acc = __builtin_amdgcn_mfma_f32_16x16x32_bf16(*(const LAS bf16x8*)(Fl + mt * 16 * 528 + 64 * s), ub[s], acc, 0, 0, 0);
                      u32x2 w; w.x = pk2(acc[0], acc[1]); w.y = pk2(acc[2], acc[3]); *(LAS u32x2*)(lds + C_ES + cl * C_ES_LD + (16 * mt + 4 * fq) * 2) = w;
                      __builtin_amdgcn_sched_barrier(0); }
              }
              __syncthreads();
            }
            if (wave == 0) {
              for (int rc = 0; rc < NREPC(1u); ++rc) { const int p = lane;
                const float* L16 = (const float*)(sl + SO_LAM16) + (g_own * 64 + p) * 2; const float lr = L16[0], li = L16[1];
                float sr = 0.f, si = 0.f;
                LAS unsigned char* es = lds + C_ES + 4 * p;
                unsigned eb[2][32];
#pragma unroll
                for (int i = 0; i < 32; ++i) eb[0][i] = *(const LAS unsigned*)(es + i * C_ES_LD);
#pragma unroll
                for (int blk = 0; blk < 8; ++blk) {
                    if (blk < 7) {
#pragma unroll
                        for (int i = 0; i < 32; ++i) eb[(blk + 1) & 1][i] = *(const LAS unsigned*)(es + (32 * (blk + 1) + i) * C_ES_LD); }
#pragma unroll
                    for (int i = 0; i < 32; ++i) { const unsigned e2 = eb[blk & 1][i];
                        if (rc + 1 == NREPC(1u)) *(LAS unsigned*)(es + (32 * blk + i) * C_ES_LD) = pk2(sr, si);
                        const float nr = lr * sr - li * si + bflo(e2), ni = lr * si + li * sr + bfhi(e2); sr = nr; si = ni; }
                    __builtin_amdgcn_sched_barrier(0);
                }
                float* so = args.out + O_SSMP + (((size_t)(l * 8 + b_own) * 32 + g_own) * 64 + p) * 2; so[0] = sr; so[1] = si; }
            } else {
              const int w7 = vcu * 7 + (wave - 1), NW7 = G * 7;
              LAS unsigned char* wlds = lds + C_WS + (wave - 1) * C_WS_SZ;
              const float* sinks = args.in[21] + l * 8;
              constexpr int NDILW = MS * 3; const int NOTH = NW7 - NDILW; const bool dilw = w7 >= NOTH;
              if (dilw) { const int u = w7 - NOTH; const int b = u / 3, gi = u % 3, sh = 2 * gi, W = 128 << sh; const bf16_t* zrow = z + (size_t)(MP + b) * DIN;
                  for (int rc = 0; rc < NREPC(2u); ++rc)
                  sample_dil_unit(zrow, ZC_DIL + 768 * gi, args.in[3 + gi] + ((size_t)(l * MS + b) * W) * 512, 1 << sh, odil + ((size_t)gi * MTP + MP + b) * 256, lse + ((size_t)gi * MTP + MP + b) * 4, wlds, lane); }
              else {
              const int gth7 = w7 * 64 + lane, NGT7 = NOTH * 64;
              for (int rc = 0; rc < NREPC(4u); ++rc)
              for (int v = w7; v < MS * 8; v += NOTH) { const int sub = lane & 15, kg = lane >> 4; const int b = v >> 3, h = v & 7, hk = h >> 2; const bf16_t* zrow = z + (size_t)(MP + b) * DIN;
                    const float* cache = args.in[2] + ((size_t)(l * MS + b) * 128) * 256 + hk * 64; f32x4 o; float lg;
                    sample_attn_core(zrow, ZC_QS + 64 * h, ZC_KS + 64 * hk, ZC_VS + 64 * hk, cache, 256, 128, 1, true, sinks[h] * LOG2E, wlds, lane, o, lg);
                    if (kg == 0) { u32x2 w; w.x = pk2(o[0], o[1]); w.y = pk2(o[2], o[3]); *(u32x2*)(obr + (size_t)(MP + b) * OBR_LD + 512 + 64 * h + 4 * sub) = w; }
              }
              { const float* LAM = (const float*)(sl + SO_LAM); const float* BBt = (const float*)(sl + SO_BB);
                for (int rc = 0; rc < NREPC(8u); ++rc)
                for (int u = w7; u < 32 * (MS / 4); u += NOTH) { const int g = u & 31, b0 = 4 * (u >> 5), p = lane;
                  const float lr = LAM[(g * 64 + p) * 2], li = LAM[(g * 64 + p) * 2 + 1];
                  f32x4 bb[8];
#pragma unroll
                  for (int i = 0; i < 8; ++i) bb[i] = *(const f32x4*)(BBt + (size_t)(g * 64 + p) * 32 + 4 * i);
                  const float* cre = args.in[16] + (size_t)(l * 32 + g) * 1024 + p; const float* cim = args.in[17] + (size_t)(l * 32 + g) * 1024 + p;
                  float cr[16], ci[16];
#pragma unroll
                  for (int hp = 0; hp < 16; ++hp) { cr[hp] = cre[hp * 64]; ci[hp] = cim[hp * 64]; }
                  const float dmine = args.in[18][l * 512 + g * 16 + (lane & 15)];
                  u32x4 w0[4], w1[4]; f32x2 h0v[4];
#pragma unroll
                  for (int j = 0; j < 4; ++j) { const size_t row = MP + b0 + j; w0[j] = *(const u32x4*)(z + row * DIN + 16 * g); w1[j] = *(const u32x4*)(z + row * DIN + 16 * g + 8);
                      h0v[j] = *(const f32x2*)(args.in[6] + (((size_t)(l * MS + b0 + j) * 32 + g) * 64 + p) * 2); }
#pragma unroll
                  for (int j = 0; j < 4; ++j) { const int b = b0 + j; const size_t row = MP + b;
                    float uu[16];
                    uu[0] = bflo(w0[j].x); uu[1] = bfhi(w0[j].x); uu[2] = bflo(w0[j].y); uu[3] = bfhi(w0[j].y); uu[4] = bflo(w0[j].z); uu[5] = bfhi(w0[j].z); uu[6] = bflo(w0[j].w); uu[7] = bfhi(w0[j].w);
                    uu[8] = bflo(w1[j].x); uu[9] = bfhi(w1[j].x); uu[10] = bflo(w1[j].y); uu[11] = bfhi(w1[j].y); uu[12] = bflo(w1[j].z); uu[13] = bfhi(w1[j].z); uu[14] = bflo(w1[j].w); uu[15] = bfhi(w1[j].w);
                    float sr = lr * h0v[j][0] - li * h0v[j][1], si = lr * h0v[j][1] + li * h0v[j][0];
#pragma unroll
                    for (int i = 0; i < 8; ++i) { sr += bb[i][0] * uu[2 * i] + bb[i][2] * uu[2 * i + 1]; si += bb[i][1] * uu[2 * i] + bb[i][3] * uu[2 * i + 1]; }
                    float* so = args.out + O_SSMS + (((size_t)(l * MS + b) * 32 + g) * 64 + p) * 2; *(f32x2*)so = (f32x2){sr, si};
                    float ymine = 0.f, umine = 0.f;
#pragma unroll
                    for (int hp = 0; hp < 16; ++hp) { const float v = wave_sum(cr[hp] * sr - ci[hp] * si); if (lane == hp) { ymine = v; umine = uu[hp]; } }
                    if (lane < 16) gact[row * 512 + 16 * g + lane] = f2bf(gelu_tanh(ymine + dmine * umine));
                  }
                } }
              for (int rc = 0; rc < NREPC(16u); ++rc)
              for (int seg = 0; seg < 8; ++seg) {
                int keep, nb, bstride, first, col0, W; size_t doff;
                if (seg < 4) { keep = (seg < 2) ? 128 : (seg == 2 ? 512 : 2048); const size_t dof = (seg == 0) ? O_SWAP : (seg == 1) ? O_D1P : (seg == 2) ? O_D4P : O_D16P; nb = 8; bstride = SEQ; first = SEQ - keep;
                    col0 = (seg == 0) ? ZC_KS : ZC_DIL + 768 * (seg - 1) + 256; W = (seg == 0) ? 256 : 512; doff = dof + (size_t)l * 8 * keep * W; }
                else { const size_t dof = (seg == 4) ? O_SWAS : (seg == 5) ? O_D1S : (seg == 6) ? O_D4S : O_D16S; keep = 1; nb = MS; bstride = 1; first = MP;
                    col0 = (seg == 4) ? ZC_KS : ZC_DIL + 768 * (seg - 5) + 256; W = (seg == 4) ? 256 : 512; doff = dof + (size_t)l * MS * W; }
                const int w8 = W / 8, nitems = nb * keep * w8, w8s = (W == 256) ? 5 : 6, ks = (keep == 1) ? 0 : (keep == 128) ? 7 : (keep == 512) ? 9 : 11;
#pragma unroll 4
                for (int it = gth7; it < nitems; it += NGT7) { const int r = it >> w8s, cc = it & (w8 - 1), b = r >> ks, t = r & (keep - 1);
                    f32x4 a, c; unpack8(*(const u32x4*)(z + (size_t)(b * bstride + first + t) * DIN + col0 + 8 * cc), a, c);
                    float* dst = args.out + doff + (size_t)r * W + 8 * cc; __builtin_nontemporal_store(a, (f32x4*)dst); __builtin_nontemporal_store(c, (f32x4*)(dst + 4)); }
              }
              }
            }
            __syncthreads();
            { const int tid = wave * 64 + lane;
            const bf16_t* KTall = (const bf16_t*)(sl + SO_KT); const bf16_t* GTall = (const bf16_t*)(sl + SO_GT); const int fr = lane & 15, fq = lane >> 4;
            LAS unsigned char* gtl = lds + C_T; LAS unsigned char* ktl = lds + C_T + 256 * 272;
            { const int g = g_own, bq = b_own;
                bf16x8 ubq[2][8];
#pragma unroll
                for (int uu = 0; uu < 2; ++uu) { const int n = (bq * 16 + wave * 2 + uu) * 16 + fr; const bf16_t* zu = z + (size_t)(16 * n + (fq >> 1)) * DIN + 16 * g + 8 * (fq & 1);
#pragma unroll
                    for (int s = 0; s < 8; ++s) ubq[uu][s] = *(const bf16x8*)(zu + (size_t)(2 * s) * DIN); }
                for (int i = tid; i < 4096; i += NTHREADS) { const int row = i >> 4, c = i & 15; *(LAS u32x4*)(gtl + row * 272 + c * 16) = *(const u32x4*)(GTall + (size_t)g * 32768 + row * 128 + c * 8); }
                { const int i = tid; *(LAS u32x4*)(ktl + i * 16) = *(const u32x4*)(KTall + (size_t)g * 4096 + i * 8); }
                __syncthreads();
#pragma unroll
                for (int uu = 0; uu < 2; ++uu) { const int ntl = wave * 2 + uu, cl = ntl * 16 + fr, nt = bq * 16 + ntl, n = nt * 16 + fr;
                    bf16x8 ub[8], sb[4];
#pragma unroll
                    for (int s = 0; s < 8; ++s) ub[s] = ubq[uu][s];
#pragma unroll
                    for (int s = 0; s < 4; ++s) sb[s] = *(const LAS bf16x8*)(lds + C_ES + cl * C_ES_LD + (32 * s + 8 * fq) * 2);
                    const LAS unsigned char* KTl = ktl + fr * 32 + 16 * (fq & 1); const int e = fq >> 1;
                    bf16x8 fe[8], fo[8];
#pragma unroll
                    for (int k = 0; k < 8; ++k) { const int lage = 2 * k - e, lago = 2 * k + 1 - e;
                        bf16x8 v = *(const LAS bf16x8*)(KTl + (lage < 0 ? 0 : lage) * 512); if (lage < 0) v = (bf16x8){0, 0, 0, 0, 0, 0, 0, 0}; fe[k] = v;
                        fo[k] = *(const LAS bf16x8*)(KTl + lago * 512); }
                    const LAS unsigned char* GTl = gtl + fr * 272 + 16 * fq;
#pragma unroll
                    for (int t = 0; t < 16; ++t) { f32x4 acc = {0.f, 0.f, 0.f, 0.f};
#pragma unroll
                        for (int s = 0; s <= t / 2; ++s) acc = __builtin_amdgcn_mfma_f32_16x16x32_bf16((t & 1) ? fo[t / 2 - s] : fe[t / 2 - s], ub[s], acc, 0, 0, 0);
#pragma unroll
                        for (int s = 0; s < 4; ++s) acc = __builtin_amdgcn_mfma_f32_16x16x32_bf16(*(const LAS bf16x8*)(GTl + t * 16 * 272 + 64 * s), sb[s], acc, 0, 0, 0);
                        u32x2 w; w.x = pk2(gelu_tanh(acc[0]), gelu_tanh(acc[1])); w.y = pk2(gelu_tanh(acc[2]), gelu_tanh(acc[3]));
                        *(u32x2*)(gact + (size_t)(16 * n + t) * 512 + 16 * g + 4 * fq) = w;
                        __builtin_amdgcn_sched_barrier(0); }
                }
            }
            }
            __syncthreads();
        }
        SEAM(pbase + 2);


        if (INL(4)) for (int rep = 0; rep < NREP(5); ++rep) { const bool dry = rep + 1 < NREP(5); (void)dry;
            { int tid_o = threadIdx.x; asm volatile("" : "+v"(tid_o)); const int tid = tid_o;
#pragma unroll 2
            for (int it = vcu * NTHREADS + tid; it < MT * 32; it += G * NTHREADS) { const int row = it >> 5, c8 = it & 31, h = c8 >> 3;
                const float l0 = lse[(size_t)row * 4 + h], l1 = lse[((size_t)MTP + row) * 4 + h], l2 = lse[((size_t)2 * MTP + row) * 4 + h];
                const float mx = fmaxf(l0, fmaxf(l1, l2)); float w0 = __expf(l0 - mx), w1 = __expf(l1 - mx), w2 = __expf(l2 - mx); const float inv = 1.f / (w0 + w1 + w2); w0 *= inv; w1 *= inv; w2 *= inv;
                f32x4 a0, b0, a1, b1, a2, b2;
                unpack8(*(const u32x4*)(odil + (size_t)row * 256 + 8 * c8), a0, b0); unpack8(*(const u32x4*)(odil + ((size_t)MTP + row) * 256 + 8 * c8), a1, b1); unpack8(*(const u32x4*)(odil + ((size_t)2 * MTP + row) * 256 + 8 * c8), a2, b2);
                *(u32x4*)(obr + (size_t)row * OBR_LD + 1024 + 8 * c8) = pack8(a0 * w0 + a1 * w1 + a2 * w2, b0 * w0 + b1 * w1 + b2 * w2); }
            }
            const FGlu f{gact, args.in[20] + l * 512, obr};
            { pg8::Gemm g{gact, wl_ + WO_GLU, MP, 512, 512, 512, 512}; pg8::StaticOrder S; S.init(MP, 512, G, bx); const EpiP<FGlu> E{f};
              pg8::gemm_phase<EpiP<FGlu>, pg8::StaticOrder, true, true>(lds, g, S, E); }
            skinny_gemm<false>(lds, gact, 512, wl_ + WO_GLU, 512, 512, 512, f, nullptr, true);
        }
        SEAM(pbase + 4);

        if (INL(5)) for (int rep = 0; rep < NREP(6); ++rep) { const bool dry = rep + 1 < NREP(6); (void)dry;
            { const FBr f{z, merged}; pg8::Gemm g{obr, wl_ + WO_BR, MP, D, 1280, OBR_LD, 1280}; pg8::StaticOrder S; S.init(MP, D, G, bx); const EpiP<FBr> E{f};
              pg8::gemm_phase<EpiP<FBr>, pg8::StaticOrder, true, true>(lds, g, S, E); }
            skinny_branches(lds, obr, wl_ + WO_BR, z, merged, wave);
        }
        SEAM(pbase + 5);

        if (INL(6)) for (int rep = 0; rep < NREP(7); ++rep) { const bool dry = rep + 1 < NREP(7); (void)dry;
            const FRes f{xb_cur, dry ? xbdum : xb_cur}; float* ssq_w = dry ? ssqdum : ssq_cur;
            { pg8::Gemm g{merged, wl_ + WO_OUT, MP, D, D, D, D}; pg8::StaticOrder S; S.init(MP, D, G, bx); const EpiR<FRes> E{f, ssq_w};
              pg8::gemm_phase<EpiR<FRes>, pg8::StaticOrder, true, true>(lds, g, S, E); }
            skinny_gemm<true>(lds, merged, D, wl_ + WO_OUT, D, D, D, f, ssq_w);
        }
        SEAM(pbase + 6);

        if (INL(7)) for (int rep = 0; rep < NREP(8); ++rep) { const bool dry = rep + 1 < NREP(8); (void)dry;
            const FUp f{ssq_cur, hid, (const LAS float*)(lds + RSTD_OFF)};
            { pg8::Gemm g{xb_cur, wl_ + WO_UP, MP, DFF, D, XLD, D}; pg8::StaticOrder S; S.init(MP, DFF, G, bx); fill_rstd(lds, ssq_cur, S); const EpiP<FUp> E{f};
              pg8::gemm_phase<EpiP<FUp>, pg8::StaticOrder, true, true>(lds, g, S, E); }
            skinny_gemm<false>(lds, xb_cur, XLD, wl_ + WO_UP, D, DFF, D, f, nullptr, true);
        }
        SEAM(pbase + 7);

        if (INL(8)) for (int rep = 0; rep < NREP(9); ++rep) { const bool dry = rep + 1 < NREP(9); (void)dry;
            const FRes f{xb_cur, dry ? xbdum : xb_cur}; float* ssq_w = dry ? ssqdum : ssq_cur;
            { pg8::Gemm g{hid, wl_ + WO_DOWN, MP, D, DFF, DFF, DFF}; pg8::StaticOrder S; S.init(MP, D, G, bx); const EpiR<FRes> E{f, ssq_w};
              pg8::gemm_phase<EpiR<FRes>, pg8::StaticOrder, true, true>(lds, g, S, E); }
            skinny_gemm<true>(lds, hid, DFF, wl_ + WO_DOWN, DFF, D, DFF, f, ssq_w);
        }
        SEAM(pbase + 8);

        if (INL(9)) for (int rep = 0; rep < NREP(10); ++rep) { const bool dry = rep + 1 < NREP(10); (void)dry;
            bf16_t* xbw = dry ? xbdum : xb_nxt; float* ssq_w = dry ? ssqdum : ssq_nxt;
            { const FPgBig f{ssq_cur, ppb, xb_cur, xbw, (const LAS float*)(lds + RSTD_OFF)}; pg8::Gemm g{xb_cur, wl_ + WO_PGP, MP, D, 1280, XLD, 1280}; pg8::StaticOrder S; S.init(MP, D, G, bx); fill_rstd(lds, ssq_cur, S); const EpiR<FPgBig> E{f, ssq_w};
              pg8::gemm_phase<EpiR<FPgBig>, pg8::StaticOrder, true, true>(lds, g, S, E); }
            skinny_ple(lds, xb_cur, wl_ + WO_PGP, ssq_cur, xbw, ssq_w);
        }
        SEAM(pbase + 9);
    }

    if (((PHM >> 11) & 1u) && IN(21)) for (int rep = 0; rep < NREP(11); ++rep) { const bool dry = rep + 1 < NREP(11);
        int tid_o = threadIdx.x; asm volatile("" : "+v"(tid_o)); const int lane = tid_o & 63;
        const float* gf = args.in[32]; const bf16_t* xfin = (const bf16_t*)(ws + WS_XB0);
        for (int m = gw; m < MT; m += NGW) {
            f32x4 v[4]; float s = 0.f;
#pragma unroll
            for (int j = 0; j < 4; ++j) { const u32x2 w = *(const u32x2*)(xfin + (size_t)m * XLD + 4 * lane + 256 * j); v[j] = (f32x4){bflo(w.x), bfhi(w.x), bflo(w.y), bfhi(w.y)};
                s += (v[j][0] * v[j][0] + v[j][1] * v[j][1]) + (v[j][2] * v[j][2] + v[j][3] * v[j][3]); }
            const float rs = rsqrtf(wave_sum(s) * (1.f / D) + EPS);
            float* yr = (dry ? (float*)(ws + WS_XDUM) : args.out) + (size_t)m * D;
#pragma unroll
            for (int j = 0; j < 4; ++j) { const f32x4 gg = *(const f32x4*)(gf + 4 * lane + 256 * j); __builtin_nontemporal_store(v[j] * rs * gg, (f32x4*)(yr + 4 * lane + 256 * j)); }
        }
    }
#undef IN
#undef SEAM
}

extern "C" void kernel_launch(void* const* d_in, const int* in_sizes, int n_in, void* d_out, int out_size, void* d_ws, size_t ws_size, hipStream_t stream) {
    static int grid = 0;
    if (grid == 0) {
        if (n_in != 33 || (size_t)out_size != O_END || ws_size < (REPM ? WS_END_PROBE : WS_END)) { fprintf(stderr, "kernel_launch: unexpected shapes: n_in %d out %d (want %zu) ws %zu (want %zu)\n", n_in, out_size, (size_t)O_END, ws_size, (size_t)WS_END); grid = -1; return; }
        int dev = 0, cus = 0;
        if (hipGetDevice(&dev) != hipSuccess || hipDeviceGetAttribute(&cus, hipDeviceAttributeMultiprocessorCount, dev) != hipSuccess) { grid = -1; return; }
        if (hipFuncSetAttribute((const void*)fwd_kernel, hipFuncAttributeMaxDynamicSharedMemorySize, LDS_BYTES) != hipSuccess) { fprintf(stderr, "kernel_launch: hipFuncSetAttribute failed\n"); grid = -1; return; }
        int per_cu = 0;
        if (hipOccupancyMaxActiveBlocksPerMultiprocessor(&per_cu, (const void*)fwd_kernel, NTHREADS, LDS_BYTES) != hipSuccess || per_cu < 1) fprintf(stderr, "kernel_launch: occupancy query says %d\n", per_cu);
        (void)hipGetLastError();
        if (cus < 256) { fprintf(stderr, "kernel_launch: built for a 256-CU device (one workgroup per (sequence, SSM group)); found %d CUs\n", cus); grid = -1; return; }
        grid = 256;
    }
    if (grid < 0) return;
    (void)hipMemsetAsync((char*)d_ws + WS_CTL, 0, CTL_BYTES, stream);
    Args a{};
    for (int i = 0; i < 33; ++i) a.in[i] = (const float*)d_in[i];
    a.out = (float*)d_out; a.ws = (unsigned char*)d_ws;
#if MK_ONE_LAUNCH
    a.ph_lo = 0; a.ph_hi = NPHASE;
    hipLaunchKernelGGL(fwd_kernel, dim3(grid), dim3(NTHREADS), LDS_BYTES, stream, a);
#else
    for (int p = 0; p < NPHASE; ++p) { a.ph_lo = p; a.ph_hi = p + 1; hipLaunchKernelGGL(fwd_kernel, dim3(grid), dim3(NTHREADS), LDS_BYTES, stream, a); }
#endif
}
```
